# Optimizing an MI355X kernel written in HIP

```python
import jax, jax.numpy as jnp
from jax import lax
import numpy as np

D_MODEL = 1024
BATCH = 2
SEQ = 16384
DEPTH = 2

GRID_W = 64
CTX_LEN = 256
HEAD_DIM = 64
N_HEADS = 8
N_KV_HEADS = 2
D_ATTN = N_HEADS * HEAD_DIM
D_CONV_A = 256
D_CONF = 256
D_MIX = D_CONV_A + D_ATTN + D_CONF
SHORT_CONV_W = 3
CONF_CONV_W = 31
WINDOW = 128
BLOCK = 128
D_FF = 4 * D_MODEL
ROPE_BASE = 10000.0
EPS = 1e-6
NEG_INF = -1e30

OFF_Q = 3 * D_CONV_A
OFF_K = OFF_Q + D_ATTN
OFF_V = OFF_K + N_KV_HEADS * HEAD_DIM
OFF_C = OFF_V + N_KV_HEADS * HEAD_DIM
D_IN = OFF_C + 2 * D_CONF

kernel_name = "hybrid_parallel_groups_diffusion_block"


def rms_norm(x, g):
    x32 = x.astype(jnp.float32)
    y = x32 * lax.rsqrt(jnp.mean(x32 * x32, axis=-1, keepdims=True) + EPS)
    return y.astype(x.dtype) * g


def layer_norm(x, g, b):
    x32 = x.astype(jnp.float32)
    mu = jnp.mean(x32, axis=-1, keepdims=True)
    xc = x32 - mu
    y = xc * lax.rsqrt(jnp.mean(xc * xc, axis=-1, keepdims=True) + EPS)
    return y.astype(x.dtype) * g + b


def modulate(h, shift, scale):
    return h * (1 + scale) + shift


def heads(t, n):
    return t.reshape(t.shape[:-1] + (n, HEAD_DIM))


def depthwise_conv(x, w, b=None):
    k = w.shape[0]
    y = lax.conv_general_dilated(
        x, w[:, None, :], window_strides=(1,), padding=[(k // 2, k // 2)],
        dimension_numbers=('NWC', 'WIO', 'NWC'), feature_group_count=x.shape[-1])
    return y if b is None else y + b


def axial_rope(t, row, col):
    d_axis = HEAD_DIM // 2
    half = d_axis // 2
    inv_freq = ROPE_BASE ** (-jnp.arange(0, d_axis, 2, dtype=jnp.float32) / d_axis)

    def rot(u, pos):
        ang = pos.astype(jnp.float32)[:, None] * inv_freq[None, :]
        cos = jnp.cos(ang)[None, :, None, :].astype(u.dtype)
        sin = jnp.sin(ang)[None, :, None, :].astype(u.dtype)
        u1, u2 = u[..., :half], u[..., half:]
        return jnp.concatenate([u1 * cos - u2 * sin, u1 * sin + u2 * cos], axis=-1)

    return jnp.concatenate([rot(t[..., :d_axis], row), rot(t[..., d_axis:], col)], axis=-1)


def window_attention(q, k, v, kc, vc, sink):
    B, S, H, dh = q.shape
    KVH = k.shape[2]
    G = H // KVH
    nb = S // BLOCK
    n_ctx = kc.shape[1]
    scale = dh ** -0.5
    qb = q.reshape(B, nb, BLOCK, KVH, G, dh)

    def band(t):
        tp = jnp.pad(t, ((0, 0), (BLOCK, BLOCK), (0, 0), (0, 0))).reshape(B, nb + 2, BLOCK, KVH, dh)
        return jnp.concatenate([tp[:, :-2], tp[:, 1:-1], tp[:, 2:]], axis=2)

    kw, vw = band(k), band(v)
    s_loc = jnp.einsum('bnqkgd,bnskd->bnkgqs', qb, kw).astype(jnp.float32) * scale
    qi = jnp.arange(BLOCK)
    si = jnp.arange(3 * BLOCK)
    rel = si[None, :] - BLOCK - qi[:, None]
    kpos = jnp.arange(nb)[:, None] * BLOCK - BLOCK + si[None, :]
    valid = (jnp.abs(rel) <= WINDOW)[None] & ((kpos >= 0) & (kpos < S))[:, None, :]
    s_loc = jnp.where(valid[None, :, None, None], s_loc, NEG_INF)
    s_ctx = jnp.einsum('bnqkgd,bckd->bnkgqc', qb, kc).astype(jnp.float32) * scale
    sink_col = jnp.broadcast_to(sink.astype(jnp.float32).reshape(1, 1, KVH, G, 1, 1),
                                s_loc.shape[:-1] + (1,))
    p = jax.nn.softmax(jnp.concatenate([s_loc, s_ctx, sink_col], axis=-1), axis=-1).astype(v.dtype)
    n_loc = 3 * BLOCK
    o = (jnp.einsum('bnkgqs,bnskd->bnqkgd', p[..., :n_loc], vw)
         + jnp.einsum('bnkgqc,bckd->bnqkgd', p[..., n_loc:n_loc + n_ctx], vc))
    return o.reshape(B, S, H * dh)


def context_attention(q, k, v, sink):
    B, C, H, dh = q.shape
    KVH = k.shape[2]
    G = H // KVH
    qg = q.reshape(B, C, KVH, G, dh)
    s = jnp.einsum('bqkgd,bckd->bkgqc', qg, k).astype(jnp.float32) * (dh ** -0.5)
    sink_col = jnp.broadcast_to(sink.astype(jnp.float32).reshape(1, KVH, G, 1, 1), s.shape[:-1] + (1,))
    p = jax.nn.softmax(jnp.concatenate([s, sink_col], axis=-1), axis=-1).astype(v.dtype)
    o = jnp.einsum('bkgqc,bckd->bqkgd', p[..., :-1], v)
    return o.reshape(B, C, H * dh)


def short_conv_mix(u, w):
    x_in, b_gate, c_gate = jnp.split(u, 3, axis=-1)
    return b_gate * depthwise_conv(c_gate * x_in, w)


def conformer_conv(u, w, b, g, beta):
    val, gate = jnp.split(u, 2, axis=-1)
    y = depthwise_conv(val * jax.nn.sigmoid(gate), w, b)
    return jax.nn.silu(layer_norm(y, g, beta))


def sq_relu_mlp(h, w1, w2):
    return jnp.square(jax.nn.relu(h @ w1)) @ w2


def setup_inputs(seed: int = 0) -> dict:
    key = jax.random.key(seed)
    ks = jax.random.split(key, 24)
    L = DEPTH

    def nrm(k, shape, s):
        return jax.random.normal(k, shape, jnp.float32) * s

    return {
        "x": nrm(ks[0], (BATCH, SEQ, D_MODEL), 1.0),
        "c": nrm(ks[1], (BATCH, D_MODEL), 1.0),
        "ctx": nrm(ks[2], (BATCH, CTX_LEN, D_MODEL), 1.0),
        "c_ctx": nrm(ks[3], (D_MODEL,), 1.0),
        "w_mod": nrm(ks[4], (L, D_MODEL, 6 * D_MODEL), 0.5 * D_MODEL ** -0.5),
        "b_mod": nrm(ks[5], (L, 6 * D_MODEL), 0.02),
        "norm1_g": 1.0 + nrm(ks[6], (L, D_MODEL), 0.05),
        "w_in": nrm(ks[7], (L, D_MODEL, D_IN), D_MODEL ** -0.5),
        "conv_a_w": nrm(ks[8], (L, SHORT_CONV_W, D_CONV_A), SHORT_CONV_W ** -0.5),
        "q_norm_g": 1.0 + nrm(ks[9], (L, HEAD_DIM), 0.05),
        "k_norm_g": 1.0 + nrm(ks[10], (L, HEAD_DIM), 0.05),
        "attn_sink": nrm(ks[11], (L, N_HEADS), 0.5),
        "conv_c_w": nrm(ks[12], (L, CONF_CONV_W, D_CONF), CONF_CONV_W ** -0.5),
        "conv_c_b": nrm(ks[13], (L, D_CONF), 0.02),
        "ln_c_g": 1.0 + nrm(ks[14], (L, D_CONF), 0.05),
        "ln_c_b": nrm(ks[15], (L, D_CONF), 0.02),
        "w_out": nrm(ks[16], (L, D_MIX, D_MODEL), D_MIX ** -0.5),
        "norm2_g": 1.0 + nrm(ks[17], (L, D_MODEL), 0.05),
        "w_mlp1": nrm(ks[18], (L, D_MODEL, D_FF), D_MODEL ** -0.5),
        "w_mlp2": nrm(ks[19], (L, D_FF, D_MODEL), D_FF ** -0.5),
    }


def reference(x, c, ctx, c_ctx, w_mod, b_mod, norm1_g, w_in, conv_a_w, q_norm_g, k_norm_g,
              attn_sink, conv_c_w, conv_c_b, ln_c_g, ln_c_b, w_out, norm2_g, w_mlp1, w_mlp2):
    S = x.shape[1]
    ROWS = S // GRID_W
    row = jnp.repeat(jnp.arange(ROWS, dtype=jnp.int32), GRID_W)
    col = jnp.tile(jnp.arange(GRID_W, dtype=jnp.int32), ROWS)
    xc = ctx
    silu_c = jax.nn.silu(c)
    silu_cc = jax.nn.silu(c_ctx)

    for i in range(DEPTH):
        last = i == DEPTH - 1
        mod_l = (silu_c @ w_mod[i] + b_mod[i])[:, None, :]
        sh1, sc1, g1, sh2, sc2, g2 = jnp.split(mod_l, 6, axis=-1)
        mod_c = silu_cc @ w_mod[i] + b_mod[i]
        csh1, csc1, cg1, csh2, csc2, cg2 = jnp.split(mod_c, 6, axis=-1)

        hc = modulate(rms_norm(xc, norm1_g[i]), csh1, csc1)
        if last:
            uc_kv = hc @ w_in[i][:, OFF_K:OFF_C]
            kc_raw, vc_raw = uc_kv[..., :OFF_V - OFF_K], uc_kv[..., OFF_V - OFF_K:]
        else:
            uc = hc @ w_in[i]
            kc_raw, vc_raw = uc[..., OFF_K:OFF_V], uc[..., OFF_V:OFF_C]
        kc = rms_norm(heads(kc_raw, N_KV_HEADS), k_norm_g[i])
        vc = heads(vc_raw, N_KV_HEADS)

        h = modulate(rms_norm(x, norm1_g[i]), sh1, sc1)
        u = h @ w_in[i]
        q = axial_rope(rms_norm(heads(u[..., OFF_Q:OFF_K], N_HEADS), q_norm_g[i]), row, col)
        k = axial_rope(rms_norm(heads(u[..., OFF_K:OFF_V], N_KV_HEADS), k_norm_g[i]), row, col)
        v = heads(u[..., OFF_V:OFF_C], N_KV_HEADS)
        y = jnp.concatenate([
            short_conv_mix(u[..., :OFF_Q], conv_a_w[i]),
            window_attention(q, k, v, kc, vc, attn_sink[i]),
            conformer_conv(u[..., OFF_C:], conv_c_w[i], conv_c_b[i], ln_c_g[i], ln_c_b[i]),
        ], axis=-1)
        x = x + g1 * (y @ w_out[i])
        x = x + g2 * sq_relu_mlp(modulate(rms_norm(x, norm2_g[i]), sh2, sc2), w_mlp1[i], w_mlp2[i])

        if not last:
            qc = rms_norm(heads(uc[..., OFF_Q:OFF_K], N_HEADS), q_norm_g[i])
            yc = jnp.concatenate([
                short_conv_mix(uc[..., :OFF_Q], conv_a_w[i]),
                context_attention(qc, kc, vc, attn_sink[i]),
                conformer_conv(uc[..., OFF_C:], conv_c_w[i], conv_c_b[i], ln_c_g[i], ln_c_b[i]),
            ], axis=-1)
            xc = xc + cg1 * (yc @ w_out[i])
            xc = xc + cg2 * sq_relu_mlp(modulate(rms_norm(xc, norm2_g[i]), csh2, csc2),
                                        w_mlp1[i], w_mlp2[i])
    return x
```

```cpp
#include <hip/hip_runtime.h>
#include <cstdio>
#include <cstdint>

template <int K> __device__ __forceinline__ float xlane_f(float v) {
    return __builtin_bit_cast(float, __builtin_amdgcn_ds_swizzle(__builtin_bit_cast(int, v), (K << 10) | 0x1F));
}
__device__ __forceinline__ float xadd32(float v) { const unsigned b = __float_as_uint(v); auto r = __builtin_amdgcn_permlane32_swap(b, b, false, false); const unsigned r0 = r[0], r1 = r[1]; return __uint_as_float(r0) + __uint_as_float(r1); }
__device__ __forceinline__ float xmax32(float v) { const unsigned b = __float_as_uint(v); auto r = __builtin_amdgcn_permlane32_swap(b, b, false, false); const unsigned r0 = r[0], r1 = r[1]; return fmaxf(__uint_as_float(r0), __uint_as_float(r1)); }
__device__ __forceinline__ float xget32(float v, bool upper) { const unsigned b = __float_as_uint(v); auto r = __builtin_amdgcn_permlane32_swap(b, b, false, false); const unsigned r0 = r[0], r1 = r[1]; return __uint_as_float(upper ? r0 : r1); }
template <int K> __device__ __forceinline__ float xadd(float v) { if constexpr (K == 32) return xadd32(v); else return v + xlane_f<K>(v); }
template <int K> __device__ __forceinline__ float xmaxk(float v) { if constexpr (K == 32) return xmax32(v); else return fmaxf(v, xlane_f<K>(v)); }

#ifndef REP_MIX
#define REP_MIX 1
#endif
#ifndef REP_ATT
#define REP_ATT 1
#endif
#ifndef REP_CONV
#define REP_CONV 1
#endif
#ifndef REP_P01
#define REP_P01 1
#endif
#ifndef REP_G0
#define REP_G0 1
#endif
#ifndef REP_G4
#define REP_G4 1
#endif
#ifndef REP_G2
#define REP_G2 1
#endif
#ifndef REP_G5
#define REP_G5 1
#endif
#ifndef REP_QK
#define REP_QK 1
#endif
#ifndef MK_PER_PHASE
#define MK_PER_PHASE 0
#endif

namespace pg8 {
#define PG8_LAS __attribute__((address_space(3)))
typedef unsigned short bf16_t;
typedef short bf16x8 __attribute__((ext_vector_type(8)));
typedef float f32x4 __attribute__((ext_vector_type(4)));
typedef unsigned u32x4 __attribute__((ext_vector_type(4)));
constexpr int BM = 256, BK = 64, HALF = 128, HTB = HALF * BK * 2, STAGE_BYTES = 8 * HTB, NXCD = 8, WGM = 8;

__host__ __device__ __forceinline__ int lds_byte(int r, int c) { return r * 128 + ((((c >> 3) ^ (r & 7)) << 4) | ((c & 7) * 2)); }
__host__ __device__ __forceinline__ void stage_rc(int b, int& R, int& C) { R = b >> 7; C = ((((b >> 4) & 7) ^ (R & 7)) << 3); }
__host__ __device__ __forceinline__ int perm32(int rho) { const int n = rho >> 4, i = rho & 15; return 8 * (i >> 2) + 4 * n + (i & 3); }

struct Unit { int pm, pn; };
struct Gemm { const bf16_t* A; const bf16_t* Bt; int M, N, K; size_t bvar; int lda = 0; size_t apanel = 0; };
__host__ __device__ __forceinline__ int variant_of(int pm) { return pm < 64 ? 0 : (pm < 128 ? 1 : 2); }

struct StaticOrder {
    int nM, nN, nwg, G, c;
    __host__ __device__ void init(int M, int N, int G_, int c_) { nM = M / BM; nN = N / BM; nwg = nM * nN; G = G_; c = c_; }
    __host__ __device__ bool next(int i, Unit& u) const {
        const long L = (long)i * G + c; if (L >= nwg) return false;
        int wgid = (int)L; { const int q = nwg / NXCD, r = nwg % NXCD, xcd = wgid % NXCD, off = wgid / NXCD; wgid = (xcd < r ? xcd * (q + 1) : r * (q + 1) + (xcd - r) * q) + off; }
        const int nig = WGM * nN, gid = wgid / nig, fm = gid * WGM, gsz = (nM - fm) < WGM ? (nM - fm) : WGM;
        u.pm = fm + ((wgid % nig) % gsz); u.pn = (wgid % nig) / gsz; return true;
    }
    __device__ __forceinline__ void a_ready(const Unit&) const {}
    __device__ __forceinline__ void done(const Unit&) const {}
};

__device__ __forceinline__ unsigned cvt_pk_bf16(float lo, float hi) { unsigned r; asm volatile("v_cvt_pk_bf16_f32 %0, %1, %2" : "=v"(r) : "v"(lo), "v"(hi)); return r; }

#define PG8_EPI_BAR() do { asm volatile("s_waitcnt lgkmcnt(0)" ::: "memory"); __builtin_amdgcn_s_barrier(); asm volatile("" ::: "memory"); } while (0)

struct EpiTabs { PG8_LAS int* US; PG8_LAS float* RS; PG8_LAS float* BT; PG8_LAS float* S1; PG8_LAS float* B1; };
template <class Sched> __device__ __forceinline__ void epi_tables(const Sched& S, const float* stat, const float* bias, int bias_vstride, int N, float eps, const EpiTabs& T) {
    int tid_ = threadIdx.x; asm volatile("" : "+v"(tid_)); const int tid = tid_;
    Unit u; S.next(0, u);
    const int v0 = variant_of(u.pm);
    int pm0 = -1, pm1 = -1, pm2 = -1, pm3 = -1, nslot = 0;
#pragma unroll 1
    for (int i = 0; i < 64; ++i) {
        if (!S.next(i, u)) break;
        int sl = 255;
        if (variant_of(u.pm) == v0) {
            if (u.pm == pm0) sl = 0; else if (u.pm == pm1) sl = 1; else if (u.pm == pm2) sl = 2; else if (u.pm == pm3) sl = 3;
            else if (nslot < 4) { sl = nslot; if (nslot == 0) pm0 = u.pm; else if (nslot == 1) pm1 = u.pm; else if (nslot == 2) pm2 = u.pm; else pm3 = u.pm; ++nslot; }
        }
        if (tid == 0) T.US[i] = sl;
    }
#pragma unroll 1
    for (int k = 0; k < nslot; ++k) { const int pm = k == 0 ? pm0 : (k == 1 ? pm1 : (k == 2 ? pm2 : pm3));
        if (tid < 256) { const f32x4 p = *(const f32x4*)(stat + (size_t)(pm * BM + tid) * 4); T.RS[k * 256 + tid] = 1.0f / sqrtf(((p[0] + p[1]) + (p[2] + p[3])) * (1.0f / 1024.0f) + eps); } }
    for (int idx = tid; idx < N / 4; idx += 512) *(PG8_LAS f32x4*)(T.BT + 4 * idx) = *(const f32x4*)(bias + (size_t)v0 * bias_vstride + 4 * idx);
    PG8_EPI_BAR();
}
__device__ __forceinline__ void epi_lookup(const EpiTabs& T, int ui, const Unit& u, const float* stat, const float* bias, int bias_vstride, float eps, const PG8_LAS float*& rsp, const PG8_LAS float*& btp) {
    const int slot = __builtin_amdgcn_readfirstlane(T.US[ui < 64 ? ui : 63]);
    if (ui < 64 && slot != 255) { rsp = T.RS + slot * 256; btp = T.BT + u.pn * BM; }
    else {
        int tid = threadIdx.x; asm volatile("" : "+v"(tid));
        if (tid < 256) { const f32x4 p = *(const f32x4*)(stat + (size_t)(u.pm * BM + tid) * 4); T.S1[tid] = 1.0f / sqrtf(((p[0] + p[1]) + (p[2] + p[3])) * (1.0f / 1024.0f) + eps); }
        else if (tid < 320) *(PG8_LAS f32x4*)(T.B1 + 4 * (tid - 256)) = *(const f32x4*)(bias + (size_t)variant_of(u.pm) * bias_vstride + u.pn * BM + 4 * (tid - 256));
        PG8_EPI_BAR();
        rsp = T.S1; btp = T.B1;
    }
}

template <int ACT> struct EpiNormAct {
    static constexpr bool PERM = true, AFTER_DRAIN = false;
    bf16_t* O; int ldc; const float* stat; const float* bias; int bias_vstride; int N; EpiTabs T; float eps; size_t opanel = 0;
    template <class Sched> __device__ __forceinline__ void prepare(const Sched& S) const { epi_tables(S, stat, bias, bias_vstride, N, eps, T); }
    __device__ __forceinline__ void operator()(const f32x4 (&acc)[2][2][4][2], const Unit& u, int wr, int wc, int fr, int fq, int ui) const {
        const PG8_LAS float* rsp; const PG8_LAS float* btp; epi_lookup(T, ui, u, stat, bias, bias_vstride, eps, rsp, btp);
        const int col0 = u.pn * BM + wc * 64 + 8 * fq;
        int bo = wc * 64 + 8 * fq, ro = wr * 64 + fr; asm volatile("" : "+v"(bo), "+v"(ro));
        f32x4 bv[2][2];
#pragma unroll
        for (int bj = 0; bj < 2; ++bj)
#pragma unroll
            for (int n = 0; n < 2; ++n) bv[bj][n] = *(const PG8_LAS f32x4*)(btp + bo + bj * 32 + 4 * n);
#pragma unroll
        for (int ai = 0; ai < 2; ++ai)
#pragma unroll
            for (int m = 0; m < 4; ++m) { const int rl = ai * HALF + wr * 64 + m * 16 + fr; const float rs = rsp[ro + ai * HALF + m * 16];
                bf16_t* rowp = O + (size_t)(u.pm * BM + rl) * ldc + (opanel ? (size_t)(col0 / ldc) * opanel + (col0 % ldc) : (size_t)col0);
#pragma unroll
                for (int bj = 0; bj < 2; ++bj) { f32x4 v0 = acc[ai][bj][m][0] * rs + bv[bj][0], v1 = acc[ai][bj][m][1] * rs + bv[bj][1];
                    if (ACT == 1) {
#pragma unroll
                        for (int e = 0; e < 4; ++e) { const float a = fmaxf(v0[e], 0.f), b = fmaxf(v1[e], 0.f); v0[e] = a * a; v1[e] = b * b; } }
                    u32x4 w; w.x = cvt_pk_bf16(v0[0], v0[1]); w.y = cvt_pk_bf16(v0[2], v0[3]); w.z = cvt_pk_bf16(v1[0], v1[1]); w.w = cvt_pk_bf16(v1[2], v1[3]);
                    *(u32x4*)(rowp + bj * 32) = w; } }
    }
};

struct EpiIn {
    static constexpr bool PERM = true, AFTER_DRAIN = false;
    bf16_t* U; const float* stat; const float* bias; const float* qg; const float* kg; const float* rope; EpiTabs T; PG8_LAS float* RT; float eps, qscale;
    template <class Sched> __device__ __forceinline__ void prepare(const Sched& S) const {
        int tid_ = threadIdx.x; asm volatile("" : "+v"(tid_));
        *(PG8_LAS f32x4*)(T.BT + 2048 + 4 * tid_) = *(const f32x4*)(rope + 4 * tid_);
        Unit u;
#pragma unroll 1
        for (int i = 0; i < 16; ++i) { if (!S.next(i, u)) break;
            if (tid_ < 128) RT[i * 128 + tid_] = rope[(size_t)((((u.pm * BM) & 16383) >> 6) + (tid_ >> 5)) * 32 + (tid_ & 31)]; }
        epi_tables(S, stat, bias, 2048, 2048, eps, T); }
    __device__ __forceinline__ void operator()(const f32x4 (&acc)[2][2][4][2], const Unit& u, int wr, int wc, int fr, int fq, int ui) const {
        const PG8_LAS float* S; const PG8_LAS float* btp; epi_lookup(T, ui, u, stat, bias, 2048, eps, S, btp);
        const int col0 = u.pn * BM + wc * 64 + 8 * fq;
        int bo = wc * 64 + 8 * fq, ro = wr * 64 + fr; asm volatile("" : "+v"(bo), "+v"(ro)); const PG8_LAS float* const Sr = S + ro;
        f32x4 bv[2][2];
#pragma unroll
        for (int bj = 0; bj < 2; ++bj)
#pragma unroll
            for (int n = 0; n < 2; ++n) bv[bj][n] = *(const PG8_LAS f32x4*)(btp + bo + bj * 32 + 4 * n);
        const bool head = (u.pn == 3 || u.pn == 4 || (u.pn == 5 && wc < 2));
        if (!head) {
#pragma unroll
            for (int ai = 0; ai < 2; ++ai)
#pragma unroll
                for (int m = 0; m < 4; ++m) { const int rl = ai * HALF + wr * 64 + m * 16 + fr; const float rs = Sr[ai * HALF + m * 16];
                    bf16_t* rowp = U + (size_t)(u.pm * BM + rl) * 2048 + col0;
#pragma unroll
                    for (int bj = 0; bj < 2; ++bj) { const f32x4 v0 = acc[ai][bj][m][0] * rs + bv[bj][0], v1 = acc[ai][bj][m][1] * rs + bv[bj][1];
                        u32x4 w; w.x = cvt_pk_bf16(v0[0], v0[1]); w.y = cvt_pk_bf16(v0[2], v0[3]); w.z = cvt_pk_bf16(v1[0], v1[1]); w.w = cvt_pk_bf16(v1[2], v1[3]);
                        *(u32x4*)(rowp + bj * 32) = w; } }
            return;
        }
        const bool isk = (u.pn == 5);
        const float* gsrc = (isk ? kg : qg) + 8 * fq; const float gmul = isk ? 1.0f : qscale;
        float gl[2][8];
#pragma unroll
        for (int bj = 0; bj < 2; ++bj)
#pragma unroll
            for (int j = 0; j < 8; ++j) gl[bj][j] = gsrc[32 * bj + j] * gmul;
        const bool upper = (fq & 2) != 0;
        int cto = 2048 + fr * 32 + 16 * (fq & 1), rto = (ui < 16 ? ui : 0) * 128 + wr * 32 + 16 * (fq & 1); asm volatile("" : "+v"(cto), "+v"(rto));
        const PG8_LAS float* const ctb = T.BT + cto; const PG8_LAS float* const rtb = RT + rto;
#pragma unroll
        for (int ai = 0; ai < 2; ++ai) {
            f32x4 q0, q1, q2, q3;
            if (ui < 16) { const PG8_LAS f32x4* rp = (const PG8_LAS f32x4*)(rtb + ai * 64); q0 = rp[0]; q1 = rp[1]; q2 = rp[2]; q3 = rp[3]; }
            else { const f32x4* rp = (const f32x4*)(rope + (size_t)((((u.pm * BM + ai * HALF + wr * 64) & 16383) >> 6) * 16 + 8 * (fq & 1)) * 2); q0 = rp[0]; q1 = rp[1]; q2 = rp[2]; q3 = rp[3]; }
            const float csr[8] = {q0[0], q0[2], q1[0], q1[2], q2[0], q2[2], q3[0], q3[2]}, snr[8] = {q0[1], q0[3], q1[1], q1[3], q2[1], q2[3], q3[1], q3[3]};
#pragma unroll
            for (int m = 0; m < 4; ++m) { const int rl = ai * HALF + wr * 64 + m * 16 + fr; const float rs = Sr[ai * HALF + m * 16]; const int row = u.pm * BM + rl;
                const PG8_LAS f32x4* cp = (const PG8_LAS f32x4*)(ctb + m * 16 * 32);
                const f32x4 c0 = cp[0], c1 = cp[1], c2 = cp[2], c3 = cp[3];
                const float csc[8] = {c0[0], c0[2], c1[0], c1[2], c2[0], c2[2], c3[0], c3[2]}, snc[8] = {c0[1], c0[3], c1[1], c1[3], c2[1], c2[3], c3[1], c3[3]};
                float ss = 0.f;
#pragma unroll
                for (int bj = 0; bj < 2; ++bj) { const f32x4 v0 = acc[ai][bj][m][0] * rs + bv[bj][0], v1 = acc[ai][bj][m][1] * rs + bv[bj][1];
                    ss += (v0[0] * v0[0] + v0[1] * v0[1]) + (v0[2] * v0[2] + v0[3] * v0[3]) + (v1[0] * v1[0] + v1[1] * v1[1]) + (v1[2] * v1[2] + v1[3] * v1[3]); }
                ss = xadd<16>(ss); ss = xadd<32>(ss);
                const float rn = __builtin_amdgcn_rsqf(ss * (1.0f / 64.0f) + eps);
                bf16_t* rowp = U + (size_t)row * 2048 + col0;
#pragma unroll
                for (int bj = 0; bj < 2; ++bj) { const f32x4 v0 = acc[ai][bj][m][0] * rs + bv[bj][0], v1 = acc[ai][bj][m][1] * rs + bv[bj][1];
                    float x[8] = {v0[0], v0[1], v0[2], v0[3], v1[0], v1[1], v1[2], v1[3]};
#pragma unroll
                    for (int j = 0; j < 8; ++j) { const float xv = x[j] * rn * gl[bj][j]; const float pv = xget32(xv, upper);
                        const float cs = bj ? csc[j] : csr[j], sn = bj ? snc[j] : snr[j];
                        x[j] = upper ? (pv * sn + xv * cs) : (xv * cs - pv * sn); }
                    u32x4 w; w.x = cvt_pk_bf16(x[0], x[1]); w.y = cvt_pk_bf16(x[2], x[3]); w.z = cvt_pk_bf16(x[4], x[5]); w.w = cvt_pk_bf16(x[6], x[7]);
                    *(u32x4*)(rowp + bj * 32) = w; } }
        }
    }
};

template <bool FINAL> struct EpiRes {
    static constexpr bool PERM = true, AFTER_DRAIN = false;
    const bf16_t* xb; bf16_t* xbo; float* out; const float* gate; int gate_vstride; float* stat_out; PG8_LAS float* P;
    template <class Sched> __device__ __forceinline__ void prepare(const Sched&) const {}
    __device__ __forceinline__ void operator()(const f32x4 (&acc)[2][2][4][2], const Unit& u, int wr, int wc, int fr, int fq, int) const {
        int tid_ = threadIdx.x; asm volatile("" : "+v"(tid_)); const int tid = tid_;
        const bf16_t* xbp = xb + (size_t)u.pm * BM * 1024; bf16_t* xop = xbo + (size_t)u.pm * BM * 1024;
        float* op = out + (size_t)u.pm * BM * 1024;
        const int col0 = u.pn * BM + wc * 64 + 8 * fq;
        int lo_ = (wr * 64 + fr) * 1024 + wc * 64 + 8 * fq; asm volatile("" : "+v"(lo_));
        const unsigned lo = (unsigned)lo_ + (unsigned)(u.pn * BM);
        const float* gp = gate + (size_t)variant_of(u.pm) * gate_vstride + col0;
        f32x4 gv[2][2];
#pragma unroll
        for (int bj = 0; bj < 2; ++bj)
#pragma unroll
            for (int n = 0; n < 2; ++n) gv[bj][n] = *(const f32x4*)(gp + bj * 32 + 4 * n);
#pragma unroll
        for (int ai = 0; ai < 2; ++ai) {
            u32x4 xr[4][2];
#pragma unroll
            for (int m = 0; m < 4; ++m)
#pragma unroll
                for (int bj = 0; bj < 2; ++bj) xr[m][bj] = *(const u32x4*)(xbp + (lo + (unsigned)((ai * HALF + m * 16) * 1024 + bj * 32)));
#pragma unroll
            for (int m = 0; m < 4; ++m) { const int rl = ai * HALF + wr * 64 + m * 16 + fr; const unsigned off = lo + (unsigned)((ai * HALF + m * 16) * 1024); float ss = 0.f;
#pragma unroll
                for (int bj = 0; bj < 2; ++bj) {
                    const u32x4 xi = xr[m][bj];
                    const f32x4 a0 = (f32x4){__uint_as_float(xi.x << 16), __uint_as_float(xi.x & 0xffff0000u), __uint_as_float(xi.y << 16), __uint_as_float(xi.y & 0xffff0000u)};
                    const f32x4 a1 = (f32x4){__uint_as_float(xi.z << 16), __uint_as_float(xi.z & 0xffff0000u), __uint_as_float(xi.w << 16), __uint_as_float(xi.w & 0xffff0000u)};
                    const f32x4 o0 = a0 + gv[bj][0] * acc[ai][bj][m][0], o1 = a1 + gv[bj][1] * acc[ai][bj][m][1];
                    if (FINAL) { *(f32x4*)(op + off + bj * 32) = o0; *(f32x4*)(op + off + bj * 32 + 4) = o1; }
                    else {
                        u32x4 w; w.x = cvt_pk_bf16(o0[0], o0[1]); w.y = cvt_pk_bf16(o0[2], o0[3]); w.z = cvt_pk_bf16(o1[0], o1[1]); w.w = cvt_pk_bf16(o1[2], o1[3]);
                        *(u32x4*)(xop + off + bj * 32) = w;
                        ss += (o0[0] * o0[0] + o0[1] * o0[1]) + (o0[2] * o0[2] + o0[3] * o0[3]) + (o1[0] * o1[0] + o1[1] * o1[1]) + (o1[2] * o1[2] + o1[3] * o1[3]); } }
                if (!FINAL) { ss = xadd<16>(ss); ss = xadd<32>(ss); if (fq == 0) P[rl * 4 + wc] = ss; } }
        }
        if (!FINAL) {
            PG8_EPI_BAR();
            if (tid < 256) { const f32x4 p = *(const PG8_LAS f32x4*)(P + tid * 4); stat_out[(size_t)(u.pm * BM + tid) * 4 + u.pn] = (p[0] + p[1]) + (p[2] + p[3]); }
        }
    }
};

template <class Epi, class Sched, bool ALIGN_EPI = false, bool SP2 = false>
__device__ __forceinline__ void gemm_phase(PG8_LAS unsigned char* lds, const Gemm g, const Sched& S, const Epi& E) {
    int tid_ = threadIdx.x; asm volatile("" : "+v"(tid_));
    const int tid = tid_, wid = __builtin_amdgcn_readfirstlane(tid >> 6), lane = tid & 63, wr = wid >> 2, wc = wid & 3, fr = lane & 15, fq = lane >> 4;
    const int K = g.K, nt = K / BK, lda = g.lda ? g.lda : g.K, ktpp = g.apanel ? lda / BK : nt; const size_t apan = g.apanel;
    unsigned voffA[2], voffB[2];
#pragma unroll
    for (int i = 0; i < 2; ++i) { int R, C; stage_rc(tid * 16 + i * 8192, R, C); const int Rb = Epi::PERM ? (64 * (R >> 5) + perm32(R & 31)) : R;
        voffA[i] = (unsigned)(R * lda + C) * 2u; voffB[i] = (unsigned)(Rb * K + C) * 2u; }
    const size_t kstep = (size_t)(BK * 2);
    const size_t hstepB = (size_t)(Epi::PERM ? 32 : HALF) * K * 2, hstepA = (size_t)HALF * lda * 2;
    const size_t tstep = (size_t)BM * K * 2, tstepA = 2 * hstepA;
    const unsigned ldsw = (unsigned)wid * 1024u;
    const int aoff = lds_byte(wr * 64 + fr, fq * 8), boff = lds_byte(wc * 32 + fr, fq * 8);
    const int aoff1 = aoff ^ 64, boff1 = boff ^ 64;
#define PG8_SA(b, h) (((b) * 2 + (h)) * HTB)
#define PG8_SB(b, h) ((4 + (b) * 2 + (h)) * HTB)
#define PG8_STAGE(bufoff, gbase, voff) do { _Pragma("unroll") for (int _i = 0; _i < 2; ++_i) \
        __builtin_amdgcn_global_load_lds((const unsigned*)((const char*)(gbase) + (voff)[_i]), (PG8_LAS unsigned*)(lds + (bufoff) + ldsw + _i * 8192), 16, 0, 0); } while (0)
#define PG8_LDA(dst, b, h) do { _Pragma("unroll") for (int m = 0; m < 4; ++m) _Pragma("unroll") for (int k = 0; k < 2; ++k) dst[m][k] = *(const PG8_LAS bf16x8*)(lds + PG8_SA(b, h) + (k ? aoff1 : aoff) + m * 2048); } while (0)
#define PG8_LDB(dst, b, h) do { _Pragma("unroll") for (int n = 0; n < 2; ++n) _Pragma("unroll") for (int k = 0; k < 2; ++k) dst[n][k] = *(const PG8_LAS bf16x8*)(lds + PG8_SB(b, h) + (k ? boff1 : boff) + n * 2048); } while (0)
#define PG8_MMA(ai, bj, At, Bt) do { __builtin_amdgcn_s_setprio(1); _Pragma("unroll") for (int m = 0; m < 4; ++m) _Pragma("unroll") for (int n = 0; n < 2; ++n) _Pragma("unroll") for (int k = 0; k < 2; ++k) \
        acc[ai][bj][m][n] = __builtin_amdgcn_mfma_f32_16x16x32_bf16(Bt[n][k], At[m][k], acc[ai][bj][m][n], 0, 0, 0); __builtin_amdgcn_s_setprio(0); } while (0)
#define PG8_WAIT_V(n) asm volatile("s_waitcnt vmcnt(" #n ")" ::: "memory")
#define PG8_WAIT_L(n) asm volatile("s_waitcnt lgkmcnt(" #n ")" ::: "memory")
#define PG8_BAR __builtin_amdgcn_s_barrier()
#define PG8_SCHED __builtin_amdgcn_sched_barrier(0)
    Unit cur, nxt; int ui = 0;
    if (!S.next(0, cur)) return;
    E.prepare(S);
    f32x4 acc[2][2][4][2];
#pragma unroll
    for (int a = 0; a < 2; ++a)
#pragma unroll
        for (int b = 0; b < 2; ++b)
#pragma unroll
            for (int m = 0; m < 4; ++m)
#pragma unroll
                for (int n = 0; n < 2; ++n) acc[a][b][m][n] = (f32x4){0.f, 0.f, 0.f, 0.f};
    bf16x8 At[4][2], B0[2][2], B1[2][2];
    const char* cA = (const char*)g.A + (size_t)cur.pm * tstepA; const char* cB = (const char*)g.Bt + (size_t)variant_of(cur.pm) * g.bvar + (size_t)cur.pn * tstep;
    S.a_ready(cur);
    if constexpr (SP2) {
        PG8_STAGE(PG8_SB(0, 0), cB, voffB); PG8_STAGE(PG8_SB(0, 1), cB + hstepB, voffB); PG8_STAGE(PG8_SA(0, 0), cA, voffA); PG8_STAGE(PG8_SA(0, 1), cA + hstepA, voffA);
        if (wr == 1) PG8_BAR;
        PG8_WAIT_V(2); PG8_BAR;
        PG8_STAGE(PG8_SB(1, 0), cB + kstep, voffB); PG8_STAGE(PG8_SA(1, 0), cA + kstep, voffA); PG8_STAGE(PG8_SB(1, 1), cB + hstepB + kstep, voffB);
        PG8_WAIT_V(6); PG8_BAR;
    } else {
        PG8_STAGE(PG8_SB(0, 0), cB, voffB); PG8_STAGE(PG8_SA(0, 0), cA, voffA); PG8_STAGE(PG8_SB(0, 1), cB + hstepB, voffB); PG8_STAGE(PG8_SA(0, 1), cA + hstepA, voffA);
        if (wr == 1) PG8_BAR;
        PG8_WAIT_V(4); PG8_BAR;
        PG8_STAGE(PG8_SB(1, 0), cB + kstep, voffB); PG8_STAGE(PG8_SA(1, 0), cA + kstep, voffA); PG8_STAGE(PG8_SB(1, 1), cB + hstepB + kstep, voffB);
        PG8_WAIT_V(6); PG8_BAR;
    }
    for (;;) {
        const bool has_next = S.next(ui + 1, nxt);
        const char* nA = has_next ? (const char*)g.A + (size_t)nxt.pm * tstepA : cA;
        const char* nB = has_next ? (const char*)g.Bt + (size_t)variant_of(nxt.pm) * g.bvar + (size_t)nxt.pn * tstep : cB;
        for (int t = 0; t < nt; t += 2) {
            const bool last = (t == nt - 2);
            const int t2 = t + 2; const size_t ak0 = (size_t)(t / ktpp) * apan + (size_t)(t % ktpp) * kstep, ak2 = (size_t)(t2 / ktpp) * apan + (size_t)(t2 % ktpp) * kstep;
            const char* a1 = cA + ak0 + kstep;
            const char* a2 = last ? nA : cA + ak2; const char* b2 = last ? nB : cB + (size_t)(t + 2) * kstep;
            const char* a3 = a2 + kstep; const char* b3 = b2 + kstep;
            if (last && has_next) S.a_ready(nxt);
            if constexpr (SP2) {
            PG8_LDB(B0, 0, 0); PG8_LDB(B1, 0, 1); PG8_SCHED; PG8_LDA(At, 0, 0); PG8_STAGE(PG8_SA(1, 1), a1 + hstepA, voffA);
            PG8_WAIT_V(8); PG8_WAIT_L(0); PG8_BAR; PG8_MMA(0, 0, At, B0); PG8_MMA(0, 1, At, B1); PG8_BAR; PG8_SCHED;
            PG8_LDA(At, 0, 1); PG8_STAGE(PG8_SB(0, 0), b2, voffB); PG8_STAGE(PG8_SB(0, 1), b2 + hstepB, voffB); PG8_STAGE(PG8_SA(0, 0), a2, voffA);
            PG8_WAIT_V(8); PG8_WAIT_L(0); PG8_BAR; PG8_MMA(1, 0, At, B0); PG8_MMA(1, 1, At, B1); PG8_BAR; PG8_SCHED;
            PG8_LDB(B0, 1, 0); PG8_LDB(B1, 1, 1); PG8_SCHED; PG8_LDA(At, 1, 0); PG8_STAGE(PG8_SA(0, 1), a2 + hstepA, voffA);
            PG8_WAIT_V(8); PG8_WAIT_L(0); PG8_BAR; PG8_MMA(0, 0, At, B0); PG8_MMA(0, 1, At, B1); PG8_BAR; PG8_SCHED;
            PG8_LDA(At, 1, 1); PG8_STAGE(PG8_SB(1, 0), b3, voffB); PG8_STAGE(PG8_SB(1, 1), b3 + hstepB, voffB); PG8_STAGE(PG8_SA(1, 0), a3, voffA);
            PG8_WAIT_V(8); PG8_WAIT_L(0); PG8_BAR; PG8_MMA(1, 0, At, B0); PG8_MMA(1, 1, At, B1); PG8_BAR; PG8_SCHED;
            } else {
            PG8_LDB(B0, 0, 0); PG8_SCHED; PG8_LDA(At, 0, 0); PG8_STAGE(PG8_SA(1, 1), a1 + hstepA, voffA);
            PG8_WAIT_L(8); PG8_BAR; PG8_WAIT_L(0); PG8_MMA(0, 0, At, B0); PG8_BAR; PG8_SCHED;
            PG8_LDB(B1, 0, 1); PG8_STAGE(PG8_SB(0, 0), b2, voffB);
            PG8_BAR; PG8_WAIT_L(0); PG8_MMA(0, 1, At, B1); PG8_BAR;
            PG8_LDA(At, 0, 1); PG8_STAGE(PG8_SA(0, 0), a2, voffA);
            PG8_BAR; PG8_WAIT_L(0); PG8_MMA(1, 0, At, B0); PG8_BAR; PG8_SCHED;
            PG8_STAGE(PG8_SB(0, 1), b2 + hstepB, voffB);
            PG8_WAIT_V(6); PG8_BAR; PG8_MMA(1, 1, At, B1); PG8_BAR;
            PG8_LDB(B0, 1, 0); PG8_SCHED; PG8_LDA(At, 1, 0); PG8_STAGE(PG8_SA(0, 1), a2 + hstepA, voffA);
            PG8_WAIT_L(8); PG8_BAR; PG8_WAIT_L(0); PG8_MMA(0, 0, At, B0); PG8_BAR; PG8_SCHED;
            PG8_LDB(B1, 1, 1); PG8_STAGE(PG8_SB(1, 0), b3, voffB);
            PG8_BAR; PG8_WAIT_L(0); PG8_MMA(0, 1, At, B1); PG8_BAR;
            PG8_LDA(At, 1, 1); PG8_STAGE(PG8_SA(1, 0), a3, voffA);
            PG8_BAR; PG8_WAIT_L(0); PG8_MMA(1, 0, At, B0); PG8_BAR; PG8_SCHED;
            PG8_STAGE(PG8_SB(1, 1), b3 + hstepB, voffB);
            PG8_WAIT_V(6); PG8_BAR; PG8_MMA(1, 1, At, B1); PG8_BAR;
            }
        }
        if constexpr (ALIGN_EPI) { if (wr == 0) PG8_BAR; }
        if constexpr (!Epi::AFTER_DRAIN) { E(acc, cur, wr, wc, fr, fq, ui); S.done(cur); }
        if (!has_next) break;
#pragma unroll
        for (int a = 0; a < 2; ++a)
#pragma unroll
            for (int b = 0; b < 2; ++b)
#pragma unroll
                for (int m = 0; m < 4; ++m)
#pragma unroll
                    for (int n = 0; n < 2; ++n) acc[a][b][m][n] = (f32x4){0.f, 0.f, 0.f, 0.f};
        cur = nxt; cA = nA; cB = nB; ++ui;
        if constexpr (ALIGN_EPI) { if (wr == 1) PG8_BAR; }
    }
    PG8_WAIT_V(0);
    if constexpr (!ALIGN_EPI) { if (wr == 0) PG8_BAR; }
    PG8_BAR;
#undef PG8_SA
#undef PG8_SB
#undef PG8_STAGE
#undef PG8_LDA
#undef PG8_LDB
#undef PG8_MMA
#undef PG8_WAIT_V
#undef PG8_WAIT_L
#undef PG8_BAR
#undef PG8_SCHED
}
}

constexpr int NWAVES = 8;
constexpr int DM = 1024, DIN = 2048, DFF = 4096, SEQ = 16384, NBATCH = 2, CTXL = 256, NLAYER = 2;
constexpr int MLAT = NBATCH * SEQ, MCTX = NBATCH * CTXL, MTOT = MLAT + MCTX;
constexpr int OFF_Q = 768, OFF_K = 1280, OFF_V = 1408, OFF_C = 1536;
constexpr int NHEAD = 8, NKV = 2, HD = 64;
constexpr float EPS = 1e-6f;
constexpr int MODW = 6 * DM;
constexpr int KSPLIT = 8;
constexpr float QSCALE = 0.125f * 1.4426950408889634f;

constexpr size_t MiB = 1u << 20;
constexpr size_t WS_CTL = 0, CTL_ZERO_BYTES = 36864;
constexpr size_t WS_MODP = 1 * MiB;
constexpr size_t WS_MOD = 3 * MiB;
constexpr size_t WS_BIAS1 = 3 * MiB + 256 * 1024;
constexpr size_t WS_BIAS2 = 3 * MiB + 512 * 1024;
constexpr size_t WS_ROPE = 3 * MiB + 768 * 1024;
constexpr size_t WS_STAT1 = 4 * MiB;
constexpr size_t WS_STAT2 = 5 * MiB;
constexpr size_t WS_STATC1 = 5 * MiB + 640 * 1024;
constexpr size_t WS_STATC2 = 5 * MiB + 704 * 1024;
constexpr size_t WS_XC = 6 * MiB;
constexpr size_t WS_WIN = 8 * MiB;
constexpr size_t WS_WOUT = 32 * MiB;
constexpr size_t WS_W1 = 36 * MiB;
constexpr size_t WS_W2 = 84 * MiB;
constexpr size_t WS_XB = 100 * MiB;
constexpr size_t WS_U = 165 * MiB;
constexpr size_t WS_Y = 425 * MiB;
constexpr size_t WS_H = 165 * MiB;
constexpr size_t WS_END = 491 * MiB;
constexpr size_t WS_SCRATCH = 491 * MiB;
static_assert(WS_H + (size_t)MTOT * DFF * 2 <= WS_Y && WS_Y + (size_t)MTOT * DM * 2 <= WS_END && WS_U + (size_t)MTOT * DIN * 2 <= WS_Y && WS_XB + (size_t)MTOT * DM * 2 <= WS_U, "ws map");
constexpr int CW_BAR = 4096;
static_assert((CW_BAR + 4224) * 4 <= (int)CTL_ZERO_BYTES, "barrier words inside the per-call memset");

constexpr int RING_OFF = 0, RING_BYTES = 131072;
constexpr int LDSCTL_OFF = RING_BYTES, MISC_OFF = LDSCTL_OFF + 320;
constexpr int EPI_US_OFF = RING_BYTES + 512;
constexpr int EPI_S_OFF = RING_BYTES + 1024;
constexpr int EPI_P_OFF = RING_BYTES + 2048;
constexpr int EPI_RS_OFF = RING_BYTES + 10240;
constexpr int EPI_BT_OFF = RING_BYTES + 14336;
constexpr int EPI_B1_OFF = RING_BYTES + 30720;
constexpr int EPI_RT_OFF = RING_BYTES + 31744;
constexpr int LDS_BYTES = RING_BYTES + 32256;
static_assert(EPI_P_OFF + 8192 <= EPI_RS_OFF && LDS_BYTES <= 163840, "LDS map");

#define GAS __attribute__((address_space(1)))
#define LAS __attribute__((address_space(3)))
typedef unsigned short bf16;
typedef unsigned v4u __attribute__((ext_vector_type(4)));
typedef unsigned v2u __attribute__((ext_vector_type(2)));
typedef float f32x4 __attribute__((ext_vector_type(4)));
typedef GAS unsigned gu32;
#define RLX_AGENT __ATOMIC_RELAXED, __HIP_MEMORY_SCOPE_AGENT
#define LDS_WAIT() asm volatile("s_waitcnt lgkmcnt(0)" ::: "memory")
typedef float f32x2_t __attribute__((ext_vector_type(2)));
typedef __bf16 bf16x2_t __attribute__((ext_vector_type(2)));
__device__ __forceinline__ unsigned pk2(float lo, float hi) { f32x2_t v = {lo, hi}; bf16x2_t b = __builtin_convertvector(v, bf16x2_t); return __builtin_bit_cast(unsigned, b); }
__device__ __forceinline__ unsigned f2bf(float f) { return pk2(f, 0.f) & 0xffffu; }
__device__ __forceinline__ float bflo(unsigned w) { return __builtin_bit_cast(float, w << 16); }
__device__ __forceinline__ float bfhi(unsigned w) { return __builtin_bit_cast(float, w & 0xffff0000u); }
__device__ __forceinline__ float bf1(bf16 h) { return __builtin_bit_cast(float, (unsigned)h << 16); }
__device__ __forceinline__ float sigmoidf_(float v) { return __builtin_amdgcn_rcpf(1.0f + __expf(-v)); }

#define XB_TMO      128
#define XB_XCNT(j)  (256  + 64 * (j))
#define XB_XSUB(j)  (1280 + 64 * (j))
#define XB_XGEN(j)  (2304 + 64 * (j))
#define XB_TOP      3328
#define XB_TOPGEN   3392
#define XB_LSUB(j)  (3456 + 16 * (j))
#define XB_LGEN(j)  (3712 + 16 * (j))
#define XB_XCCOF(i) (3968 + (i))
#define XCD_BAR_WORDS 4224
#define XB_SPIN_CAP (1u << 18)
__device__ __forceinline__ unsigned xb_ld(unsigned* p)              { return __hip_atomic_load(p, __ATOMIC_RELAXED, __HIP_MEMORY_SCOPE_AGENT); }
__device__ __forceinline__ unsigned xb_add(unsigned* p, unsigned v) { return __hip_atomic_fetch_add(p, v, __ATOMIC_RELAXED, __HIP_MEMORY_SCOPE_AGENT); }
__device__ __forceinline__ unsigned xb_xcc_id() { return (unsigned)__builtin_amdgcn_s_getreg((3 << 11) | 20) & 0xFu; }
#define XB_SPIN(cond, bar) do { unsigned _sp = 0; while (cond) { __builtin_amdgcn_s_sleep(1); \
    if ((++_sp & 255u) == 0u) { if (xb_ld(&(bar)[XB_TMO])) break; if (_sp > XB_SPIN_CAP) { atomicAdd(&(bar)[XB_TMO], 1u); break; } } } } while (0)
struct XcdBarrier { unsigned* bar; unsigned x; volatile LAS unsigned* st; };
__device__ __forceinline__ XcdBarrier xcd_barrier_post(unsigned* bar, volatile LAS unsigned* st) {
    XcdBarrier b; b.bar = bar; b.x = xb_xcc_id(); b.st = st;
    if (threadIdx.x == 0) (void)xb_add(&bar[XB_XCNT(b.x)], 1u);
    return b;
}
__device__ __forceinline__ void xcd_barrier_complete(unsigned* bar, unsigned x, unsigned& nloc, unsigned& nx) {
    const unsigned G = gridDim.x * gridDim.y * gridDim.z;
    unsigned sum, cnt, mine, sp = 0u;
    for (;;) {
        sum = 0u; cnt = 0u; mine = 0u;
#pragma unroll
        for (unsigned j = 0; j < 16; ++j) { const unsigned c = xb_ld(&bar[XB_XCNT(j)]); sum += c; cnt += (c > 0u) ? 1u : 0u; mine = (j == x) ? c : mine; }
        if (sum == G) break;
        __builtin_amdgcn_s_sleep(1);
        if ((++sp & 255u) == 0u) { if (xb_ld(&bar[XB_TMO])) break; if (sp > XB_SPIN_CAP) { atomicAdd(&bar[XB_TMO], 1u); break; } }
    }
    nloc = mine > 0u ? mine : 1u; nx = cnt > 0u ? cnt : 1u;
}
__device__ __forceinline__ void xcd_barrier(const XcdBarrier& b) {
    asm volatile("s_waitcnt vmcnt(0)" ::: "memory");
    __syncthreads();
    if (threadIdx.x == 0) {
        unsigned* bar = b.bar;
        __builtin_amdgcn_s_waitcnt(0);
        unsigned nloc = b.st[0], nx = b.st[1];
        if (nloc == 0u) { xcd_barrier_complete(bar, b.x, nloc, nx); b.st[0] = nloc; b.st[1] = nx; }
        const unsigned old = xb_add(&bar[XB_XSUB(b.x)], 1u);
        const unsigned gen = old / nloc;
        if (old + 1u == (gen + 1u) * nloc) {
            __builtin_amdgcn_fence(__ATOMIC_RELEASE, "agent");
            asm volatile("s_waitcnt vmcnt(0)" ::: "memory");
            const unsigned og = xb_add(&bar[XB_TOP], 1u);
            const unsigned tg = og / nx;
            if (og + 1u == (tg + 1u) * nx) xb_add(&bar[XB_TOPGEN], 1u);
            else XB_SPIN(xb_ld(&bar[XB_TOPGEN]) == tg, bar);
            __builtin_amdgcn_fence(__ATOMIC_ACQUIRE, "agent");
            xb_add(&bar[XB_XGEN(b.x)], 1u);
            asm volatile("s_waitcnt vmcnt(0)" ::: "memory");
        } else {
            XB_SPIN(xb_ld(&bar[XB_XGEN(b.x)]) == gen, bar);
            __builtin_amdgcn_fence(__ATOMIC_ACQUIRE, "agent");
            asm volatile("s_waitcnt vmcnt(0)" ::: "memory");
        }
    }
    __syncthreads();
}

__device__ __forceinline__ void xcc_local_barrier(const XcdBarrier& b) {
    asm volatile("s_waitcnt vmcnt(0)" ::: "memory");
    __syncthreads();
    if (threadIdx.x == 0) {
        unsigned* bar = b.bar;
        __builtin_amdgcn_s_waitcnt(0);
        const unsigned nloc = b.st[0];
        const unsigned old = xb_add(&bar[XB_LSUB(b.x)], 1u);
        const unsigned gen = old / nloc;
        if (old + 1u == (gen + 1u) * nloc) { xb_add(&bar[XB_LGEN(b.x)], 1u); }
        else { XB_SPIN(xb_ld(&bar[XB_LGEN(b.x)]) == gen, bar); }
        __builtin_amdgcn_fence(__ATOMIC_ACQUIRE, "agent");
        asm volatile("s_waitcnt vmcnt(0)" ::: "memory");
    }
    __syncthreads();
}

struct Args {
    const float* in[20]; float* out; unsigned char* ws; int ph_lo, ph_hi;
};
struct Frame {
    LAS unsigned char* lds;
    int tid, lane, wave, vcu, G;
    const float *x, *c, *ctx, *c_ctx, *w_mod, *b_mod, *norm1_g, *w_in, *conv_a_w, *q_norm_g, *k_norm_g, *attn_sink, *conv_c_w, *conv_c_b, *ln_c_g, *ln_c_b, *w_out, *norm2_g, *w_mlp1, *w_mlp2;
    float* out;
    float *modp, *mod, *bias1, *bias2, *rope, *stat1, *stat2, *statc1, *statc2, *xc;
    bf16 *win_t, *wout_t, *w1_t, *w2_t, *xb, *u, *y, *h;
};

__device__ __forceinline__ float wave_sum(float v) { v = xadd<1>(v); v = xadd<2>(v); v = xadd<4>(v); v = xadd<8>(v); v = xadd<16>(v); return xadd<32>(v); }

__device__ __forceinline__ void sincos_d(double x, double& s, double& c) {
    const double TWO_PI = 6.283185307179586476925286766559;
    const double k = rint(x / TWO_PI); const double r = x - k * TWO_PI, r2 = r * r;
    double ts = r, tc = 1.0; s = r; c = 1.0;
#pragma unroll 1
    for (int i = 1; i <= 18; ++i) { tc *= -r2 / (double)((2 * i - 1) * (2 * i)); c += tc; ts *= -r2 / (double)((2 * i) * (2 * i + 1)); s += ts; }
}
__device__ __forceinline__ void p0_phase(Frame& F) {
    LAS float* sl = (LAS float*)(F.lds + RING_OFF);
    for (int item = blockIdx.x; item < NLAYER * KSPLIT * 12; item += F.G) {
        const int l = item / (KSPLIT * 12), rr = item % (KSPLIT * 12), ks = rr / 12, cc = rr % 12, n = cc * 512 + F.tid;
        __syncthreads();
        if (F.tid < 384) { const int r = F.tid >> 7, kk = F.tid & 127; const float cv = (r < 2) ? F.c[r * DM + ks * 128 + kk] : F.c_ctx[ks * 128 + kk]; sl[F.tid] = cv / (1.0f + expf(-cv)); }
        __syncthreads();
        const float* W = F.w_mod + (size_t)l * DM * MODW + (size_t)(ks * 128) * MODW + n;
        float a0 = 0.f, a1 = 0.f, a2 = 0.f;
#pragma unroll 8
        for (int kk = 0; kk < 128; ++kk) { const float w = W[(size_t)kk * MODW]; a0 += sl[kk] * w; a1 += sl[128 + kk] * w; a2 += sl[256 + kk] * w; }
        float* o = F.modp + ((size_t)(ks * NLAYER + l) * 3) * MODW + n;
        o[0] = a0; o[MODW] = a1; o[2 * MODW] = a2;
    }
    __syncthreads();
    const int gw = F.vcu * NWAVES + F.wave, NGW = F.G * NWAVES;
    for (int row = gw; row < MTOT; row += NGW) {
        const float* src = (row < MLAT) ? F.x + (size_t)row * DM : F.ctx + (size_t)(row - MLAT) * DM;
        const f32x4* xr = (const f32x4*)src + F.lane;
        f32x4 v[4]; float q[4];
#pragma unroll
        for (int j = 0; j < 4; ++j) { v[j] = xr[64 * j]; q[j] = wave_sum((v[j].x * v[j].x + v[j].y * v[j].y) + (v[j].z * v[j].z + v[j].w * v[j].w)); }
        unsigned long long* o8 = (unsigned long long*)(F.xb + (size_t)row * DM) + F.lane;
#pragma unroll
        for (int j = 0; j < 4; ++j) o8[64 * j] = (unsigned long long)pk2(v[j].x, v[j].y) | ((unsigned long long)pk2(v[j].z, v[j].w) << 32);
        if (F.lane == 0) *(f32x4*)(F.stat1 + (size_t)row * 4) = (f32x4){q[0], q[1], q[2], q[3]};
        if (row >= MLAT) {
#pragma unroll
            for (int j = 0; j < 4; ++j) { float p = (v[j].x * v[j].x + v[j].y * v[j].y) + (v[j].z * v[j].z + v[j].w * v[j].w);
                p = xadd<1>(p); p = xadd<2>(p); p = xadd<4>(p); p = xadd<8>(p);
                if ((F.lane & 15) == 0) F.statc1[(size_t)(row - MLAT) * 16 + 4 * j + (F.lane >> 4)] = p; }
        }
    }
    if (blockIdx.x == F.G - 1) {
        const float inv_freq[16] = {1.0f, 0.5623413324356079f, 0.3162277638912201f, 0.17782793939113617f, 0.10000000149011612f, 0.05623413249850273f, 0.03162277489900589f, 0.017782794311642647f,
                                    0.009999999776482582f, 0.005623413249850273f, 0.003162277629598975f, 0.0017782794311642647f, 0.0010000000474974513f, 0.000562341301701963f, 0.0003162277571391314f, 0.00017782794020604342f};
        for (int idx = F.tid; idx < 256 * 16; idx += NWAVES * 64) {
            const int pos = idx >> 4, i = idx & 15;
            float fr = 1.0f;
#pragma unroll
            for (int j = 0; j < 16; ++j) fr = (i == j) ? inv_freq[j] : fr;
            const float ang = (float)pos * fr; double s, c; sincos_d((double)ang, s, c);
            F.rope[idx * 2] = (float)c; F.rope[idx * 2 + 1] = (float)s;
        }
    }
}

__device__ __forceinline__ void p1_transpose_item(Frame& F, const float* W, int K, int N, bf16* WT, size_t vstride, int nvar, const float* gvec, int layer, int scoff, LAS float* scr, int item) {
    const int lane = F.lane;
    const int nblk = N / 32, kb = item / nblk, nb = item % nblk, k0 = 64 * kb, n0 = 32 * nb;
    LAS float* gsl = scr + 64 * 33;
#pragma unroll 8
    for (int i = 0; i < 32; ++i) { const int kk = 2 * i + (lane >> 5); scr[kk * 33 + (lane & 31)] = W[(size_t)(k0 + kk) * N + n0 + (lane & 31)]; }
    if (gvec) {
        const float g = gvec[k0 + lane];
#pragma unroll
        for (int v = 0; v < 3; ++v) { float s = F.b_mod[layer * MODW + scoff + k0 + lane];
#pragma unroll
            for (int p = 0; p < KSPLIT; ++p) s += F.modp[((size_t)(p * NLAYER + layer) * 3 + v) * MODW + scoff + k0 + lane];
            gsl[v * 64 + lane] = g * (1.0f + s); }
    }
    LDS_WAIT(); asm volatile("" ::: "memory");
    const int c = lane & 7;
    for (int v = 0; v < nvar; ++v) {
        float sc[8];
#pragma unroll
        for (int e = 0; e < 8; ++e) sc[e] = gvec ? gsl[v * 64 + 8 * c + e] : 1.0f;
#pragma unroll
        for (int j = 0; j < 4; ++j) { const int n = (lane >> 3) + 8 * j; const LAS float* s = scr + (8 * c) * 33 + n;
            v4u o; o.x = pk2(s[0 * 33] * sc[0], s[1 * 33] * sc[1]); o.y = pk2(s[2 * 33] * sc[2], s[3 * 33] * sc[3]); o.z = pk2(s[4 * 33] * sc[4], s[5 * 33] * sc[5]); o.w = pk2(s[6 * 33] * sc[6], s[7 * 33] * sc[7]);
            *(v4u*)(WT + (size_t)v * vstride + (size_t)(n0 + n) * K + k0 + 8 * c) = o; }
    }
    LDS_WAIT(); asm volatile("" ::: "memory");
}
__device__ __forceinline__ void p1_phase(Frame& F) {
    {
        LAS float* shl = (LAS float*)(F.lds + RING_OFF);
        LAS float* red = shl + 3 * 1024;
        for (int item = blockIdx.x; item < NLAYER * 96; item += F.G) {
            const int l = item / 96, j = item % 96; const bool is_in = j < 32;
            const int N = is_in ? DIN : DFF, c0 = (is_in ? j : j - 32) * 64, shoff = is_in ? 0 : 3 * DM;
            const float* W = (is_in ? F.w_in + (size_t)l * DM * DIN : F.w_mlp1 + (size_t)l * DM * DFF);
            __syncthreads();
            for (int idx = F.tid; idx < 3 * 1024; idx += NWAVES * 64) { const int v = idx >> 10, k = idx & 1023; float s = F.b_mod[l * MODW + shoff + k];
#pragma unroll
                for (int p = 0; p < KSPLIT; ++p) s += F.modp[((size_t)(p * NLAYER + l) * 3 + v) * MODW + shoff + k];
                shl[idx] = s; }
            __syncthreads();
            const int col = F.tid & 63, kg = F.tid >> 6;
            const float* Wp = W + (size_t)(kg * 128) * N + c0 + col;
            float a0 = 0.f, a1 = 0.f, a2 = 0.f;
#pragma unroll 8
            for (int kk = 0; kk < 128; ++kk) { const float w = Wp[(size_t)kk * N]; const int k = kg * 128 + kk; a0 += shl[k] * w; a1 += shl[1024 + k] * w; a2 += shl[2048 + k] * w; }
            red[(kg * 3 + 0) * 64 + col] = a0; red[(kg * 3 + 1) * 64 + col] = a1; red[(kg * 3 + 2) * 64 + col] = a2;
            __syncthreads();
            if (F.tid < 192) { const int v = F.tid >> 6, cc = F.tid & 63; float s = 0.f;
#pragma unroll
                for (int g = 0; g < 8; ++g) s += red[(g * 3 + v) * 64 + cc];
                float* dst = is_in ? F.bias1 + ((size_t)l * 3 + v) * DIN : F.bias2 + ((size_t)l * 3 + v) * DFF;
                dst[c0 + cc] = s; }
        }
        __syncthreads();
    }
    for (int idx = blockIdx.x * (NWAVES * 64) + F.tid; idx < NLAYER * 3 * MODW; idx += F.G * NWAVES * 64) {
        const int l = idx / (3 * MODW), rem = idx % (3 * MODW), v = rem / MODW, n = rem % MODW;
        float s = F.b_mod[l * MODW + n];
#pragma unroll
        for (int p = 0; p < KSPLIT; ++p) s += F.modp[((size_t)(p * NLAYER + l) * 3 + v) * MODW + n];
        F.mod[idx] = s;
    }
    LAS float* scr = (LAS float*)(F.lds + RING_OFF + F.wave * 16384);
    const int gw = F.vcu * NWAVES + F.wave, NGW = F.G * NWAVES;
    constexpr int I_IN = (DM / 64) * (DIN / 32), I_1 = (DM / 64) * (DFF / 32), I_O = (DM / 64) * (DM / 32), I_2 = (DFF / 64) * (DM / 32), I_L = I_IN + I_1 + I_O + I_2;
    for (int it = gw; it < NLAYER * I_L; it += NGW) {
        const int l = it / I_L; int r = it % I_L;
        if (r < I_IN) { p1_transpose_item(F, F.w_in + (size_t)l * DM * DIN, DM, DIN, F.win_t + (size_t)l * 3 * DIN * DM, (size_t)DIN * DM, 3, F.norm1_g + l * DM, l, 1 * DM, scr, r); continue; } r -= I_IN;
        if (r < I_1) { p1_transpose_item(F, F.w_mlp1 + (size_t)l * DM * DFF, DM, DFF, F.w1_t + (size_t)l * 3 * DFF * DM, (size_t)DFF * DM, 3, F.norm2_g + l * DM, l, 4 * DM, scr, r); continue; } r -= I_1;
        if (r < I_O) { p1_transpose_item(F, F.w_out + (size_t)l * DM * DM, DM, DM, F.wout_t + (size_t)l * DM * DM, 0, 1, nullptr, l, 0, scr, r); continue; } r -= I_O;
        p1_transpose_item(F, F.w_mlp2 + (size_t)l * DFF * DM, DFF, DM, F.w2_t + (size_t)l * DM * DFF, 0, 1, nullptr, l, 0, scr, r);
    }
}

typedef short cg_bf16x8 __attribute__((ext_vector_type(8)));
template <int MODE> __device__ __forceinline__ void ctx_gemm(Frame& F, const bf16* A, const bf16* Bt, int K, int ct0, int nct,
                                                            bf16* O, int ldo, const float* stat_in, const float* vecp  ,
                                                            const float* xi, float* xo, float* stat_out, const float* hnq = nullptr, const float* hnk = nullptr) {
    const int lane = F.lane, wave = F.wave, tid = F.tid, fr = lane & 15, fq = lane >> 4;
    LAS float* red = (LAS float*)(F.lds + RING_OFF);
    const int kslice = K / NWAVES;
    for (int it = blockIdx.x; it < 8 * nct; it += F.G) {
        const int rt = it & 7, ct = ct0 + (it >> 3), r0 = rt * 64, n0 = ct * 64;
        f32x4 acc[4][4];
#pragma unroll
        for (int mi = 0; mi < 4; ++mi)
#pragma unroll
            for (int ni = 0; ni < 4; ++ni) acc[mi][ni] = (f32x4){0.f, 0.f, 0.f, 0.f};
        const bf16* ap = A + (size_t)(r0 + fr) * K + wave * kslice + 8 * fq;
        const bf16* bp = Bt + (size_t)(n0 + fr) * K + wave * kslice + 8 * fq;
#pragma unroll 1
        for (int kc = 0; kc < kslice; kc += 128) {
            cg_bf16x8 af[4][4], bf[4][4];
#pragma unroll
            for (int kk = 0; kk < 4; ++kk)
#pragma unroll
                for (int i = 0; i < 4; ++i) { af[kk][i] = *(const cg_bf16x8*)(ap + (size_t)(16 * i) * K + kc + 32 * kk); bf[kk][i] = *(const cg_bf16x8*)(bp + (size_t)(16 * i) * K + kc + 32 * kk); }
#pragma unroll
            for (int kk = 0; kk < 4; ++kk)
#pragma unroll
                for (int mi = 0; mi < 4; ++mi)
#pragma unroll
                    for (int ni = 0; ni < 4; ++ni) acc[mi][ni] = __builtin_amdgcn_mfma_f32_16x16x32_bf16(bf[kk][ni], af[kk][mi], acc[mi][ni], 0, 0, 0);
        }
        __syncthreads();
#pragma unroll
        for (int mi = 0; mi < 4; ++mi)
#pragma unroll
            for (int ni = 0; ni < 4; ++ni) *(LAS f32x4*)(red + wave * 4096 + (16 * mi + fr) * 64 + 16 * ni + 4 * fq) = acc[mi][ni];
        __syncthreads();
        const int rl = tid >> 3, c8 = (tid & 7) * 8, row = r0 + rl, col = n0 + c8;
        f32x4 v0 = (f32x4){0.f, 0.f, 0.f, 0.f}, v1 = v0;
#pragma unroll
        for (int w = 0; w < NWAVES; ++w) { v0 += *(const LAS f32x4*)(red + w * 4096 + rl * 64 + c8); v1 += *(const LAS f32x4*)(red + w * 4096 + rl * 64 + c8 + 4); }
        if (MODE == 0 || MODE == 2) {
            float ss = 0.f;
#pragma unroll
            for (int j = 0; j < 4; ++j) { const f32x4 p = *(const f32x4*)(stat_in + (size_t)row * 16 + 4 * j); ss += (p[0] + p[1]) + (p[2] + p[3]); }
            const float rs = 1.0f / sqrtf(ss * (1.0f / 1024.0f) + EPS);
            const f32x4 b0 = *(const f32x4*)(vecp + col), b1 = *(const f32x4*)(vecp + col + 4);
            v0 = v0 * rs + b0; v1 = v1 * rs + b1;
            if (MODE == 0 && hnq != nullptr && ct >= OFF_Q / 64 && ct < OFF_V / 64) {
                float ss = (v0[0] * v0[0] + v0[1] * v0[1]) + (v0[2] * v0[2] + v0[3] * v0[3]) + (v1[0] * v1[0] + v1[1] * v1[1]) + (v1[2] * v1[2] + v1[3] * v1[3]);
                ss = xadd<1>(ss); ss = xadd<2>(ss); ss = xadd<4>(ss);
                const float rn = 1.0f / sqrtf(ss * (1.0f / 64.0f) + EPS);
                const bool isq = ct < OFF_K / 64; const float* gp = (isq ? hnq : hnk) + c8; const float gm = isq ? QSCALE * rn : rn;
                const f32x4 g0 = *(const f32x4*)gp, g1 = *(const f32x4*)(gp + 4);
                v0 = v0 * g0 * gm; v1 = v1 * g1 * gm;
            }
            if (MODE == 2) {
#pragma unroll
                for (int e = 0; e < 4; ++e) { const float a = fmaxf(v0[e], 0.f), b = fmaxf(v1[e], 0.f); v0[e] = a * a; v1[e] = b * b; } }
            v4u w; w.x = pk2(v0[0], v0[1]); w.y = pk2(v0[2], v0[3]); w.z = pk2(v1[0], v1[1]); w.w = pk2(v1[2], v1[3]);
            *(v4u*)(O + (size_t)(MLAT + row) * ldo + col) = w;
        } else {
            const f32x4 g0 = *(const f32x4*)(vecp + col), g1 = *(const f32x4*)(vecp + col + 4);
            const f32x4 a0 = *(const f32x4*)(xi + (size_t)row * DM + col), a1 = *(const f32x4*)(xi + (size_t)row * DM + col + 4);
            const f32x4 o0 = a0 + g0 * v0, o1 = a1 + g1 * v1;
            *(f32x4*)(xo + (size_t)row * DM + col) = o0; *(f32x4*)(xo + (size_t)row * DM + col + 4) = o1;
            v4u w; w.x = pk2(o0[0], o0[1]); w.y = pk2(o0[2], o0[3]); w.z = pk2(o1[0], o1[1]); w.w = pk2(o1[2], o1[3]);
            *(v4u*)(O + (size_t)(MLAT + row) * ldo + col) = w;
            float ss = (o0[0] * o0[0] + o0[1] * o0[1]) + (o0[2] * o0[2] + o0[3] * o0[3]) + (o1[0] * o1[0] + o1[1] * o1[1]) + (o1[2] * o1[2] + o1[3] * o1[3]);
            ss = xadd<1>(ss); ss = xadd<2>(ss); ss = xadd<4>(ss);
            if ((tid & 7) == 0) stat_out[(size_t)row * 16 + ct] = ss;
        }
    }
    __syncthreads();
}

constexpr int CV_OB = 65536 + 1024;
constexpr int CV_ST = CV_OB + 64 * 256 * 2;
static_assert(94 * 256 * 4 <= RING_BYTES && CV_ST + 512 <= RING_BYTES, "conv LDS map");
__device__ __forceinline__ void unpack8(const v4u w, float (&f)[8]) { f[0] = bflo(w.x); f[1] = bfhi(w.x); f[2] = bflo(w.y); f[3] = bfhi(w.y); f[4] = bflo(w.z); f[5] = bfhi(w.z); f[6] = bflo(w.w); f[7] = bfhi(w.w); }
__device__ __forceinline__ void conv_tile(Frame& F, int layer, int ti) {
    const int tid = F.tid, r0 = ti * 64;
    int s0, s1;
    if (r0 < MLAT) { s0 = r0 & ~(SEQ - 1); s1 = s0 + SEQ; } else { s0 = MLAT + ((r0 - MLAT) & ~(CTXL - 1)); s1 = s0 + CTXL; }
    LAS float* zl = (LAS float*)(F.lds + RING_OFF);
    LAS bf16* ob = (LAS bf16*)(F.lds + RING_OFF + CV_OB);
    LAS float* st = (LAS float*)(F.lds + RING_OFF + CV_ST);
    int cg_ = tid & 31; asm volatile("" : "+v"(cg_)); const int cg = cg_;
    const char* ub = (const char*)F.u;
    v4u zv[6], zg[6]; bool zok[6];
#pragma unroll
    for (int i = 0; i < 6; ++i) { const int rr = (tid >> 5) + 16 * i, row = r0 - 15 + rr; zok[i] = (rr < 94) && (row >= s0) && (row < s1);
        const unsigned off = (unsigned)(zok[i] ? row : r0) * (unsigned)(DIN * 2) + (unsigned)((OFF_C + 8 * cg) * 2); zv[i] = *(const v4u*)(ub + off); zg[i] = *(const v4u*)(ub + off + 512); }
    const int rb = r0 + 4 * (tid >> 5);
    v4u ax[6], ac[6]; bool aok[6];
#pragma unroll
    for (int k = 0; k < 6; ++k) { const int row = rb - 1 + k; aok[k] = (row >= s0) && (row < s1);
        const unsigned off = (unsigned)(aok[k] ? row : r0) * (unsigned)(DIN * 2) + (unsigned)(16 * cg); ax[k] = *(const v4u*)(ub + off); ac[k] = *(const v4u*)(ub + off + 1024); }
    __syncthreads();
#pragma unroll
    for (int i = 0; i < 6; ++i) { const int rr = (tid >> 5) + 16 * i; float a[8], g[8]; unpack8(zv[i], a); unpack8(zg[i], g);
        f32x4 z0, z1;
#pragma unroll
        for (int e = 0; e < 4; ++e) { z0[e] = zok[i] ? a[e] * sigmoidf_(g[e]) : 0.f; z1[e] = zok[i] ? a[4 + e] * sigmoidf_(g[4 + e]) : 0.f; }
        if (rr < 94) { *(LAS f32x4*)(zl + rr * 256 + 8 * cg) = z0; *(LAS f32x4*)(zl + rr * 256 + 8 * cg + 4) = z1; } }
    {
        v4u ab[4];
#pragma unroll
        for (int k = 0; k < 4; ++k) ab[k] = *(const v4u*)(ub + (unsigned)(rb + k) * (unsigned)(DIN * 2) + (unsigned)(512 + 16 * cg));
        const float* wa = F.conv_a_w + (size_t)layer * 3 * 256 + 8 * cg;
        float w0[8], w1[8], w2[8];
#pragma unroll
        for (int e = 0; e < 8; ++e) { w0[e] = wa[e]; w1[e] = wa[256 + e]; w2[e] = wa[512 + e]; }
        float pm[8], pc[8], pn[8];
        { float x[8], c[8]; unpack8(ax[0], x); unpack8(ac[0], c);
#pragma unroll
          for (int e = 0; e < 8; ++e) pm[e] = aok[0] ? x[e] * c[e] : 0.f;
          unpack8(ax[1], x); unpack8(ac[1], c);
#pragma unroll
          for (int e = 0; e < 8; ++e) pc[e] = aok[1] ? x[e] * c[e] : 0.f; }
#pragma unroll
        for (int k = 0; k < 4; ++k) { float x[8], c[8], b[8]; unpack8(ax[k + 2], x); unpack8(ac[k + 2], c); unpack8(ab[k], b);
#pragma unroll
            for (int e = 0; e < 8; ++e) pn[e] = aok[k + 2] ? x[e] * c[e] : 0.f;
            float y[8];
#pragma unroll
            for (int e = 0; e < 8; ++e) y[e] = b[e] * (w0[e] * pm[e] + w1[e] * pc[e] + w2[e] * pn[e]);
            v4u o; o.x = pk2(y[0], y[1]); o.y = pk2(y[2], y[3]); o.z = pk2(y[4], y[5]); o.w = pk2(y[6], y[7]);
            *(v4u*)(F.y + (size_t)(rb + k) * DM + 8 * cg) = o;
#pragma unroll
            for (int e = 0; e < 8; ++e) { pm[e] = pc[e]; pc[e] = pn[e]; } }
    }
    __syncthreads();
    int c_ = tid & 255; asm volatile("" : "+v"(c_));
    const int c = c_, half = tid >> 8;
    float acc[32];
    {
        float w[31];
#pragma unroll
        for (int j = 0; j < 31; ++j) w[j] = F.conv_c_w[(size_t)layer * 31 * 256 + j * 256 + c];
        const float bias = F.conv_c_b[layer * 256 + c];
#pragma unroll
        for (int i = 0; i < 32; ++i) acc[i] = bias;
#pragma unroll
        for (int r = 0; r < 62; ++r) { const float zv1 = zl[(half * 32 + r) * 256 + c];
#pragma unroll
            for (int i = 0; i < 32; ++i) { const int j = r - i; if (j >= 0 && j <= 30) acc[i] += w[j] * zv1; } }
    }
    __syncthreads();
#pragma unroll
    for (int i = 0; i < 32; ++i) zl[(half * 32 + i) * 256 + c] = acc[i];
    __syncthreads();
    {
        const int t = tid >> 3, part = tid & 7, lane = tid & 63; float sm = 0.f;
#pragma unroll 8
        for (int i = 0; i < 32; ++i) sm += zl[t * 256 + part * 32 + ((i + lane) & 31)];
        sm = xadd<1>(sm); sm = xadd<2>(sm); sm = xadd<4>(sm);
        const float mean = sm * (1.0f / 256.0f); float q = 0.f;
#pragma unroll 8
        for (int i = 0; i < 32; ++i) { const float d = zl[t * 256 + part * 32 + ((i + lane) & 31)] - mean; q += d * d; }
        q = xadd<1>(q); q = xadd<2>(q); q = xadd<4>(q);
        if (part == 0) { st[t * 2] = mean; st[t * 2 + 1] = 1.0f / sqrtf(q * (1.0f / 256.0f) + EPS); }
    }
    __syncthreads();
    {
        const float g = F.ln_c_g[layer * 256 + c], be = F.ln_c_b[layer * 256 + c];
#pragma unroll
        for (int i = 0; i < 32; ++i) { const int t = half * 32 + i; const float v = (acc[i] - st[t * 2]) * st[t * 2 + 1] * g + be;
            ob[t * 256 + c] = (bf16)f2bf(v * sigmoidf_(v)); }
    }
    __syncthreads();
#pragma unroll
    for (int i = 0; i < 4; ++i) { const int row = (tid >> 5) + 16 * i; const v4u v = *(const LAS v4u*)(ob + row * 256 + 8 * cg); *(v4u*)(F.y + (size_t)(r0 + row) * DM + 768 + 8 * cg) = v; }
}

typedef float f32x16 __attribute__((ext_vector_type(16)));
typedef short bf16x8_t __attribute__((ext_vector_type(8)));
typedef short s16x4_t __attribute__((ext_vector_type(4)));
constexpr int KSTR = 144, VSTR = 192;
constexpr int ATT_VA = 384 * KSTR, ATT_VB = 256 * KSTR;
constexpr int ATT_OST = 256 * KSTR + 256 * VSTR;
constexpr int ATT_LW = ATT_OST + 8 * 4096;
static_assert(ATT_VA + 384 * VSTR <= RING_BYTES && ATT_LW + 8 * 256 <= RING_BYTES, "attention LDS map");
__device__ __forceinline__ int crow(int r, int hi) { return (r & 3) + 8 * (r >> 2) + 4 * hi; }
__device__ __forceinline__ unsigned cvtpk_s(float lo, float hi) { f32x2_t v = {lo, hi}; bf16x2_t b = __builtin_convertvector(v, bf16x2_t); return __builtin_bit_cast(unsigned, b); }
__device__ __forceinline__ s16x4_t vtr(const LAS unsigned char* p) { return __builtin_bit_cast(s16x4_t, __builtin_amdgcn_ds_read_tr16_b64_v4i16((LAS s16x4_t*)p)); }

__device__ __forceinline__ void attn_stage(Frame& F, int row0, int nkeys, int kvh, int voff) {
    for (int idx = F.tid; idx < nkeys * 8; idx += NWAVES * 64) { const int key = idx >> 3, c = idx & 7;
        const bf16* src = F.u + (size_t)(row0 + key) * DIN + kvh * HD + 8 * c;
        const v4u kv = *(const v4u*)(src + OFF_K), vv = *(const v4u*)(src + OFF_V);
        *(LAS v4u*)(F.lds + key * KSTR + 16 * c) = kv; *(LAS v4u*)(F.lds + voff + key * VSTR + 16 * c) = vv; }
}
template <int MASK> __device__ __forceinline__ void attn_half_tile(bf16x8_t (&ka)[4], const LAS unsigned char* kpn_, const LAS unsigned char* vp_, const bf16x8_t (&qf)[2][4], f32x16 (&o)[2][2], float (&lsum)[2], float negshift, int hh, int kb, int qi0) {
    unsigned kpi = (unsigned)(size_t)kpn_, vpi = (unsigned)(size_t)vp_; asm volatile("" : "+v"(kpi), "+v"(vpi));
    const LAS unsigned char* kpn = (const LAS unsigned char*)(size_t)kpi; const LAS unsigned char* vp = (const LAS unsigned char*)(size_t)vpi;
    f32x16 p0, p1;
#pragma unroll
    for (int r = 0; r < 16; ++r) { p0[r] = negshift; p1[r] = negshift; }
#pragma unroll
    for (int ds = 0; ds < 4; ++ds) { p0 = __builtin_amdgcn_mfma_f32_32x32x16_bf16(ka[ds], qf[0][ds], p0, 0, 0, 0); p1 = __builtin_amdgcn_mfma_f32_32x32x16_bf16(ka[ds], qf[1][ds], p1, 0, 0, 0); }
    __builtin_amdgcn_sched_barrier(0);
#pragma unroll
    for (int ds = 0; ds < 4; ++ds) ka[ds] = *(const LAS bf16x8_t*)(kpn + ds * 32);
    s16x4_t vlo[2], vhi[2];
#pragma unroll
    for (int db = 0; db < 2; ++db) { vlo[db] = vtr(vp + db * 64); vhi[db] = vtr(vp + 8 * VSTR + db * 64); }
    __builtin_amdgcn_sched_barrier(0);
    float s0 = 0.f, s1 = 0.f;
#pragma unroll
    for (int r = 0; r < 16; ++r) {
        float e0 = __builtin_amdgcn_exp2f(p0[r]), e1 = __builtin_amdgcn_exp2f(p1[r]);
        if (MASK == 1) { const int kidx = kb + crow(r, hh); e0 = (kidx >= qi0) ? e0 : 0.f; e1 = (kidx >= qi0 + 32) ? e1 : 0.f; }
        if (MASK == 2) { const int kidx = kb + crow(r, hh); e0 = (kidx <= qi0) ? e0 : 0.f; e1 = (kidx <= qi0 + 32) ? e1 : 0.f; }
        p0[r] = e0; p1[r] = e1; s0 += e0; s1 += e1; }
    lsum[0] += s0; lsum[1] += s1;
#pragma unroll
    for (int ks = 0; ks < 2; ++ks) {
        v4u w0, w1;
        w0.x = cvtpk_s(p0[8 * ks + 0], p0[8 * ks + 1]); w0.y = cvtpk_s(p0[8 * ks + 2], p0[8 * ks + 3]); w0.z = cvtpk_s(p0[8 * ks + 4], p0[8 * ks + 5]); w0.w = cvtpk_s(p0[8 * ks + 6], p0[8 * ks + 7]);
        w1.x = cvtpk_s(p1[8 * ks + 0], p1[8 * ks + 1]); w1.y = cvtpk_s(p1[8 * ks + 2], p1[8 * ks + 3]); w1.z = cvtpk_s(p1[8 * ks + 4], p1[8 * ks + 5]); w1.w = cvtpk_s(p1[8 * ks + 6], p1[8 * ks + 7]);
        const bf16x8_t pa0 = __builtin_bit_cast(bf16x8_t, w0), pa1 = __builtin_bit_cast(bf16x8_t, w1);
        bf16x8_t vf[2];
#pragma unroll
        for (int db = 0; db < 2; ++db) vf[db] = (bf16x8_t){vlo[db][0], vlo[db][1], vlo[db][2], vlo[db][3], vhi[db][0], vhi[db][1], vhi[db][2], vhi[db][3]};
        if (ks == 0) {
#pragma unroll
            for (int db = 0; db < 2; ++db) { vlo[db] = vtr(vp + 16 * VSTR + db * 64); vhi[db] = vtr(vp + 24 * VSTR + db * 64); }
            __builtin_amdgcn_sched_barrier(0);
        }
#pragma unroll
        for (int db = 0; db < 2; ++db) {
            o[0][db] = __builtin_amdgcn_mfma_f32_32x32x16_bf16(pa0, vf[db], o[0][db], 0, 0, 0);
            o[1][db] = __builtin_amdgcn_mfma_f32_32x32x16_bf16(pa1, vf[db], o[1][db], 0, 0, 0); }
    }
}
__device__ __forceinline__ void attn_unit(Frame& F, int layer, int item) {
    const int lane = F.lane, wave = F.wave, r32 = lane & 31, hh = lane >> 5;
    const bool lat = item < NBATCH * NKV * (SEQ / 128);
    int b, kvh, qb, qrow0;
    if (lat) { b = item / (NKV * (SEQ / 128)); const int r = item % (NKV * (SEQ / 128)); kvh = r / (SEQ / 128); qb = r % (SEQ / 128); qrow0 = b * SEQ + qb * 128; }
    else { const int it = item - NBATCH * NKV * (SEQ / 128); b = it >> 2; kvh = (it >> 1) & 1; qb = it & 1; qrow0 = MLAT + b * CTXL + qb * 128; }
    const int crow0 = MLAT + b * CTXL;
    const int h = kvh * 4 + (wave >> 1), th = wave & 1;
    float mq = fabsf(F.q_norm_g[layer * HD + lane]), mk = fabsf(F.k_norm_g[layer * HD + lane]);
    mq = xmaxk<1>(mq); mq = xmaxk<2>(mq); mq = xmaxk<4>(mq); mq = xmaxk<8>(mq); mq = xmaxk<16>(mq); mq = xmaxk<32>(mq);
    mk = xmaxk<1>(mk); mk = xmaxk<2>(mk); mk = xmaxk<4>(mk); mk = xmaxk<8>(mk); mk = xmaxk<16>(mk); mk = xmaxk<32>(mk);
    const float shift = 8.0f * 1.03f * 1.4426950408889634f * mq * mk, negshift = -shift;
    bf16x8_t qf[2][4];
#pragma unroll
    for (int s = 0; s < 2; ++s) { const bf16* qp = F.u + (size_t)(qrow0 + 64 * th + 32 * s + r32) * DIN + OFF_Q + h * HD + 8 * hh;
#pragma unroll
        for (int ds = 0; ds < 4; ++ds) qf[s][ds] = *(const bf16x8_t*)(qp + 16 * ds); }
    f32x16 o[2][2];
#pragma unroll
    for (int s = 0; s < 2; ++s)
#pragma unroll
        for (int db = 0; db < 2; ++db)
#pragma unroll
            for (int r = 0; r < 16; ++r) o[s][db][r] = 0.f;
    float lsum[2] = {0.f, 0.f};
    const int qi0 = 64 * th + r32;
    const int kfo = r32 * KSTR + hh * 16;
    const int vfo = (4 * hh + ((lane & 15) >> 2)) * VSTR + (16 * ((lane >> 4) & 1) + 4 * (lane & 3)) * 2;
    const LAS unsigned char* L = F.lds;
    bf16x8_t ka[4];
    if (lat) {
        const int s_lo = (qb == 0) ? 128 : 0, s_hi = (qb == SEQ / 128 - 1) ? 256 : 384;
        {
            const int row_s0 = b * SEQ + 128 * (qb - 1);
            v4u kr[6], vr[6];
#pragma unroll
            for (int i = 0; i < 6; ++i) { const int idx = F.tid + 512 * i, key = idx >> 3, c = idx & 7; const int keyc = (key >= s_lo && key < s_hi) ? key : 128;
                const bf16* src = F.u + (size_t)(row_s0 + keyc) * DIN + kvh * HD + 8 * c; kr[i] = *(const v4u*)(src + OFF_K); vr[i] = *(const v4u*)(src + OFF_V); }
            __syncthreads();
#pragma unroll
            for (int i = 0; i < 6; ++i) { const int idx = F.tid + 512 * i, key = idx >> 3, c = idx & 7;
                *(LAS v4u*)(F.lds + key * KSTR + 16 * c) = kr[i]; *(LAS v4u*)(F.lds + ATT_VA + key * VSTR + 16 * c) = vr[i]; }
        }
        __syncthreads();
        {
            const LAS unsigned char* k0 = L + ((qb > 0) ? 64 * th : 128) * KSTR + kfo;
#pragma unroll
            for (int ds = 0; ds < 4; ++ds) ka[ds] = *(const LAS bf16x8_t*)(k0 + ds * 32);
        }
        if (qb > 0) {
#pragma unroll 1
            for (int hk = 2 * th; hk < 4; ++hk) attn_half_tile<1>(ka, L + (32 * hk + 32) * KSTR + kfo, L + ATT_VA + (32 * hk) * VSTR + vfo, qf, o, lsum, negshift, hh, 32 * hk, qi0);
        }
#pragma unroll 1
        for (int hk = 0; hk < 4; ++hk) attn_half_tile<0>(ka, L + (128 + 32 * hk + 32) * KSTR + kfo, L + ATT_VA + (128 + 32 * hk) * VSTR + vfo, qf, o, lsum, negshift, hh, 0, 0);
        if (qb < SEQ / 128 - 1) {
#pragma unroll 1
            for (int hk = 0; hk < 2 * th + 2; ++hk) attn_half_tile<2>(ka, L + (256 + 32 * hk + 32) * KSTR + kfo, L + ATT_VA + (256 + 32 * hk) * VSTR + vfo, qf, o, lsum, negshift, hh, 32 * hk, qi0);
        }
    }
    {
        v4u kr[4], vr[4];
#pragma unroll
        for (int i = 0; i < 4; ++i) { const int idx = F.tid + 512 * i, key = idx >> 3, c = idx & 7;
            const bf16* src = F.u + (size_t)(crow0 + key) * DIN + kvh * HD + 8 * c; kr[i] = *(const v4u*)(src + OFF_K); vr[i] = *(const v4u*)(src + OFF_V); }
        __syncthreads();
#pragma unroll
        for (int i = 0; i < 4; ++i) { const int idx = F.tid + 512 * i, key = idx >> 3, c = idx & 7;
            *(LAS v4u*)(F.lds + key * KSTR + 16 * c) = kr[i]; *(LAS v4u*)(F.lds + ATT_VB + key * VSTR + 16 * c) = vr[i]; }
    }
    __syncthreads();
#pragma unroll
    for (int ds = 0; ds < 4; ++ds) ka[ds] = *(const LAS bf16x8_t*)(L + kfo + ds * 32);
#pragma unroll 1
    for (int hk = 0; hk < 8; ++hk) attn_half_tile<0>(ka, L + (32 * hk + 32) * KSTR + kfo, L + ATT_VB + (32 * hk) * VSTR + vfo, qf, o, lsum, negshift, hh, 0, 0);
    const float sinkt = __builtin_amdgcn_exp2f(F.attn_sink[layer * NHEAD + h] * 1.4426950408889634f - shift);
    LAS float* lw = (LAS float*)(F.lds + ATT_LW + wave * 256);
    LAS bf16* stg = (LAS bf16*)(F.lds + ATT_OST + wave * 4096);
#pragma unroll
    for (int s = 0; s < 2; ++s) { const float lt = xadd32(lsum[s]) + sinkt; if (hh == 0) lw[s * 32 + r32] = 1.0f / lt; }
    LDS_WAIT(); asm volatile("" ::: "memory");
    int sb_w = ATT_OST + wave * 4096 + (4 * hh * 64 + r32) * 2, lb_r = ATT_LW + wave * 256 + 4 * hh * 4, sb_r = ATT_OST + wave * 4096 + ((lane >> 3) * 64 + (lane & 7) * 8) * 2;
    asm volatile("" : "+v"(sb_w), "+v"(lb_r), "+v"(sb_r));
#pragma unroll
    for (int s = 0; s < 2; ++s) {
#pragma unroll
        for (int r = 0; r < 16; ++r) { const int ro = (r & 3) + 8 * (r >> 2); const float inv = *(const LAS float*)(F.lds + lb_r + (s * 32 + ro) * 4);
#pragma unroll
            for (int db = 0; db < 2; ++db) *(LAS bf16*)(F.lds + sb_w + (ro * 64 + db * 32) * 2) = (bf16)f2bf(o[s][db][r] * inv); }
        LDS_WAIT(); asm volatile("" ::: "memory");
        bf16* yp = F.y + (size_t)(qrow0 + 64 * th + 32 * s + (lane >> 3)) * DM + 256 + h * HD + (lane & 7) * 8;
#pragma unroll
        for (int i = 0; i < 4; ++i) { const v4u v = *(const LAS v4u*)(F.lds + sb_r + i * 8 * 64 * 2); *(v4u*)(yp + (size_t)(i * 8) * DM) = v; }
        LDS_WAIT(); asm volatile("" ::: "memory");
    }
}
__device__ __forceinline__ void mixer_attn_phase(Frame& F, int layer) {
    const bool last = layer == NLAYER - 1;
    const int nunits = NBATCH * NKV * (SEQ / 128) + (last ? 0 : NBATCH * NKV * 2);
    for (int rep = 0; rep < REP_ATT; ++rep)
    for (int it = blockIdx.x; it < nunits; it += F.G) attn_unit(F, layer, it);
}
__device__ __forceinline__ void mixer_conv_phase(Frame& F, int layer) {
    const bool last = layer == NLAYER - 1;
    const int ntiles = (last ? MLAT : MTOT) / 64;
    const int nlat = MLAT / 64, nlr = (nlat - (int)blockIdx.x + F.G - 1) / F.G;
    for (int rep = 0; rep < REP_CONV; ++rep)
    for (int i = 0; ; ++i) { const int ti = (i < nlr) ? (int)blockIdx.x + i * F.G : nlat + (F.G - 1 - (int)blockIdx.x) + (i - nlr) * F.G; if (ti >= ntiles) break; conv_tile(F, layer, ti); }
}

constexpr int N_PHASES = 2 + 5 * NLAYER;
typedef const __attribute__((address_space(4))) Args* KArgs;
__device__ __forceinline__ void make_frame(Frame& F, KArgs a, LAS unsigned char* lds) {
    asm volatile("" : "+s"(a));
    F.lds = lds;
    { int t_ = threadIdx.x; asm volatile("" : "+v"(t_)); F.tid = t_; } F.lane = F.tid & 63; F.wave = __builtin_amdgcn_readfirstlane(F.tid >> 6);
    F.G = gridDim.x; { const int bx = blockIdx.x; F.vcu = (F.G % 8 == 0) ? (bx % 8) * (F.G / 8) + bx / 8 : bx; }
    F.x = a->in[0]; F.c = a->in[1]; F.ctx = a->in[2]; F.c_ctx = a->in[3]; F.w_mod = a->in[4]; F.b_mod = a->in[5]; F.norm1_g = a->in[6]; F.w_in = a->in[7];
    F.conv_a_w = a->in[8]; F.q_norm_g = a->in[9]; F.k_norm_g = a->in[10]; F.attn_sink = a->in[11]; F.conv_c_w = a->in[12]; F.conv_c_b = a->in[13]; F.ln_c_g = a->in[14]; F.ln_c_b = a->in[15];
    F.w_out = a->in[16]; F.norm2_g = a->in[17]; F.w_mlp1 = a->in[18]; F.w_mlp2 = a->in[19];
    F.out = a->out;
    unsigned char* ws = a->ws;
    F.modp = (float*)(ws + WS_MODP); F.mod = (float*)(ws + WS_MOD); F.bias1 = (float*)(ws + WS_BIAS1); F.bias2 = (float*)(ws + WS_BIAS2); F.rope = (float*)(ws + WS_ROPE);
    F.stat1 = (float*)(ws + WS_STAT1); F.stat2 = (float*)(ws + WS_STAT2); F.statc1 = (float*)(ws + WS_STATC1); F.statc2 = (float*)(ws + WS_STATC2); F.xc = (float*)(ws + WS_XC);
    F.win_t = (bf16*)(ws + WS_WIN); F.wout_t = (bf16*)(ws + WS_WOUT); F.w1_t = (bf16*)(ws + WS_W1); F.w2_t = (bf16*)(ws + WS_W2);
    F.xb = (bf16*)(ws + WS_XB); F.u = (bf16*)(ws + WS_U); F.y = (bf16*)(ws + WS_Y); F.h = (bf16*)(ws + WS_H);
}
__global__ void __launch_bounds__(NWAVES * 64, 2) mk_fwd(Args args_unused) {
    extern __shared__ __attribute__((aligned(16))) unsigned char lds[];
    LAS unsigned char* const ldsp = (LAS unsigned char*)lds;
    const KArgs ka = (KArgs)__builtin_amdgcn_kernarg_segment_ptr();
    const int tid0 = threadIdx.x;
    for (int u = tid0; u < (LDS_BYTES - LDSCTL_OFF) / 4; u += NWAVES * 64) ((LAS unsigned*)(ldsp + LDSCTL_OFF))[u] = 0u;
    __syncthreads();
    const int lo = ka->ph_lo, hi = ka->ph_hi;
#if MK_PER_PHASE
#define GRID_BAR() do { } while (0)
#else
    XcdBarrier bar = xcd_barrier_post((unsigned*)((gu32*)(ka->ws + WS_CTL) + CW_BAR), (volatile LAS unsigned*)(ldsp + MISC_OFF) + 8);
#define GRID_BAR() xcd_barrier(bar)
#endif
#define IN(k) (lo <= (k) && (k) < hi)
#define SEAM(k) do { if (IN(k) && IN((k) + 1)) GRID_BAR(); } while (0)
#if MK_PER_PHASE
#define SEAM_L(k) SEAM(k)
#else
#define SEAM_L(k) do { if (IN(k) && IN((k) + 1)) { if (((volatile LAS unsigned*)(ldsp + MISC_OFF))[12]) xcc_local_barrier(bar); else GRID_BAR(); } } while (0)
#endif

    for (int rep01 = 0; rep01 < REP_P01; ++rep01) {
#ifndef SKP0
    if (IN(0)) { Frame F; make_frame(F, ka, ldsp); p0_phase(F); }
#endif
    SEAM(0);
#ifndef SKP1
    if (IN(1)) { Frame F; make_frame(F, ka, ldsp); p1_phase(F); }
#endif
#if !MK_PER_PHASE
    if (rep01 == 0) { int t_ = threadIdx.x; asm volatile("" : "+v"(t_)); if (t_ == 0) (void)xb_add(&bar.bar[XB_XCCOF(__builtin_amdgcn_readfirstlane((int)blockIdx.x) & 255)], bar.x + 1u); }
#endif
    SEAM(1);
#if !MK_PER_PHASE
    if (rep01 == 0) {
        int t_ = threadIdx.x; asm volatile("" : "+v"(t_));
        volatile LAS unsigned* misc = (volatile LAS unsigned*)(ldsp + MISC_OFF);
        const unsigned G_ = gridDim.x;
        if (t_ < 256 && (unsigned)t_ < G_) { const unsigned a = xb_ld(&bar.bar[XB_XCCOF(t_)]), r = xb_ld(&bar.bar[XB_XCCOF(t_ & 7)]);
            bool bad = (a != r) || (a == 0u);
            if (t_ < 8) { const unsigned o = xb_ld(&bar.bar[XB_XCCOF((t_ + 1) & 7)]), o2 = xb_ld(&bar.bar[XB_XCCOF((t_ + 2) & 7)]), o3 = xb_ld(&bar.bar[XB_XCCOF((t_ + 3) & 7)]), o4 = xb_ld(&bar.bar[XB_XCCOF((t_ + 4) & 7)]);
                bad = bad || (o == a) || (o2 == a) || (o3 == a) || (o4 == a); }
            if (bad) misc[13] = 1u; }
        __syncthreads();
        if (t_ == 0) misc[12] = (misc[13] == 0u && (G_ % 8u) == 0u && G_ >= 16u && G_ <= 256u) ? 1u : 0u;
        __syncthreads();
    }
#endif
    }
#pragma unroll 1
    for (int layer = 0; layer < NLAYER; ++layer) {
        const int pb = 2 + 5 * layer; const bool last = layer == NLAYER - 1;
#ifndef SKG0
        if (IN(pb + 0)) for (int rep = 0; rep < REP_G0; ++rep) {
            Frame F; make_frame(F, ka, ldsp);
            const bf16* wv2 = F.win_t + (size_t)layer * 3 * DIN * DM + (size_t)2 * DIN * DM;
#if defined(PROBE_LDC)
            if (layer == 0) { pg8::Gemm g{F.h, F.win_t + (size_t)layer * 3 * DIN * DM, MLAT, DIN, DM, (size_t)DIN * DM * 2, PROBE_LDA}; pg8::StaticOrder S; S.init(MLAT, DIN, F.G, (int)blockIdx.x); pg8::EpiNormAct<0> Ed{F.h, PROBE_LDC, F.stat1, F.bias1 + (size_t)layer * 3 * DIN, DIN, DIN, pg8::EpiTabs{(LAS int*)(ldsp + EPI_US_OFF), (LAS float*)(ldsp + EPI_RS_OFF), (LAS float*)(ldsp + EPI_BT_OFF), (LAS float*)(ldsp + EPI_S_OFF), (LAS float*)(ldsp + EPI_B1_OFF)}, EPS};
                pg8::gemm_phase<pg8::EpiNormAct<0>, pg8::StaticOrder, true, true>(ldsp + RING_OFF, g, S, Ed); }
#endif
            ctx_gemm<0>(F, F.xb + (size_t)MLAT * DM, wv2, DM, last ? OFF_K / 64 : 0, last ? (OFF_C - OFF_K) / 64 : DIN / 64, F.u, DIN, F.statc1, F.bias1 + ((size_t)layer * 3 + 2) * DIN, nullptr, nullptr, nullptr, F.q_norm_g + layer * HD, F.k_norm_g + layer * HD);
            pg8::Gemm g{F.xb, F.win_t + (size_t)layer * 3 * DIN * DM, MLAT, DIN, DM, (size_t)DIN * DM * 2};
            pg8::StaticOrder S; S.init(MLAT, DIN, F.G, (int)blockIdx.x);
            pg8::EpiIn E{F.u, F.stat1, F.bias1 + (size_t)layer * 3 * DIN, F.q_norm_g + layer * HD, F.k_norm_g + layer * HD, F.rope, pg8::EpiTabs{(LAS int*)(ldsp + EPI_US_OFF), (LAS float*)(ldsp + EPI_RS_OFF), (LAS float*)(ldsp + EPI_BT_OFF), (LAS float*)(ldsp + EPI_S_OFF), (LAS float*)(ldsp + EPI_B1_OFF)}, (LAS float*)(ldsp + EPI_P_OFF)  , EPS, QSCALE};
            pg8::gemm_phase<pg8::EpiIn, pg8::StaticOrder, true, true>(ldsp + RING_OFF, g, S, E);
        }
#endif
        SEAM(pb + 0);
#ifndef SKMX
        if (IN(pb + 1)) { for (int rep = 0; rep < REP_MIX; ++rep) { Frame F; make_frame(F, ka, ldsp); mixer_attn_phase(F, layer); } { Frame F; make_frame(F, ka, ldsp); mixer_conv_phase(F, layer); } }
#endif
        SEAM(pb + 1);
#ifndef SKG3
        if (IN(pb + 2)) {
            Frame F; make_frame(F, ka, ldsp);
            if (!last) ctx_gemm<1>(F, F.y + (size_t)MLAT * DM, F.wout_t + (size_t)layer * DM * DM, DM, 0, DM / 64, F.xb, DM, nullptr, F.mod + ((size_t)layer * 3 + 2) * MODW + 2 * DM, F.ctx, F.xc, F.statc2);
            pg8::Gemm g{F.y, F.wout_t + (size_t)layer * DM * DM, MLAT, DM, DM, 0};
            pg8::StaticOrder S; S.init(MLAT, DM, F.G, (int)blockIdx.x);
            for (int rep = 1; rep < REP_G2; ++rep) { pg8::EpiRes<false> E{F.xb, (bf16*)(ka->ws + WS_SCRATCH), nullptr, F.mod + (size_t)layer * 3 * MODW + 2 * DM, MODW, (float*)(ka->ws + WS_SCRATCH + 80 * MiB), (LAS float*)(ldsp + EPI_P_OFF)};
                pg8::gemm_phase<pg8::EpiRes<false>, pg8::StaticOrder, true, true>(ldsp + RING_OFF, g, S, E); }
            pg8::EpiRes<false> E{F.xb, F.xb, nullptr, F.mod + (size_t)layer * 3 * MODW + 2 * DM, MODW, F.stat2, (LAS float*)(ldsp + EPI_P_OFF)};
            pg8::gemm_phase<pg8::EpiRes<false>, pg8::StaticOrder, true, true>(ldsp + RING_OFF, g, S, E);
        }
#endif
        SEAM_L(pb + 2);
#ifndef SKG4
        if (IN(pb + 3)) for (int rep = 0; rep < REP_G4; ++rep) {
            Frame F; make_frame(F, ka, ldsp);
            int par = __builtin_amdgcn_readfirstlane(((int)blockIdx.x >> 3) & 1); asm volatile("" : "+s"(par));
#pragma unroll 1
            for (int pass = 0; pass < 2; ++pass) {
            if (pass == par) {
            if (!last) ctx_gemm<2>(F, F.xb + (size_t)MLAT * DM, F.w1_t + (size_t)layer * 3 * DFF * DM + (size_t)2 * DFF * DM, DM, 0, DFF / 64, F.h, DFF, F.statc2, F.bias2 + ((size_t)layer * 3 + 2) * DFF, nullptr, nullptr, nullptr);
            } else {
            pg8::Gemm g{F.xb, F.w1_t + (size_t)layer * 3 * DFF * DM, MLAT, DFF, DM, (size_t)DFF * DM * 2};
            pg8::StaticOrder S; S.init(MLAT, DFF, F.G, (int)blockIdx.x);
            pg8::EpiNormAct<1> E{F.h, DM, F.stat2, F.bias2 + (size_t)layer * 3 * DFF, DFF, DFF, pg8::EpiTabs{(LAS int*)(ldsp + EPI_US_OFF), (LAS float*)(ldsp + EPI_RS_OFF), (LAS float*)(ldsp + EPI_BT_OFF), (LAS float*)(ldsp + EPI_S_OFF), (LAS float*)(ldsp + EPI_B1_OFF)}, EPS, (size_t)MLAT * DM};
            pg8::gemm_phase<pg8::EpiNormAct<1>, pg8::StaticOrder, true, true>(ldsp + RING_OFF, g, S, E);
            } }
        }
#endif
        SEAM_L(pb + 3);
#ifndef SKG5
        if (IN(pb + 4)) {
            Frame F; make_frame(F, ka, ldsp);
            if (!last) ctx_gemm<1>(F, F.h + (size_t)MLAT * DFF, F.w2_t + (size_t)layer * DM * DFF, DFF, 0, DM / 64, F.xb, DM, nullptr, F.mod + ((size_t)layer * 3 + 2) * MODW + 5 * DM, F.xc, F.xc, F.statc1);
            pg8::Gemm g{F.h, F.w2_t + (size_t)layer * DM * DFF, MLAT, DM, DFF, 0, DM, (size_t)MLAT * DM * 2};
            pg8::StaticOrder S; S.init(MLAT, DM, F.G, (int)blockIdx.x);
            for (int rep = 1; rep < REP_G5; ++rep) { pg8::EpiRes<false> E{F.xb, (bf16*)(ka->ws + WS_SCRATCH), nullptr, F.mod + (size_t)layer * 3 * MODW + 5 * DM, MODW, (float*)(ka->ws + WS_SCRATCH + 80 * MiB), (LAS float*)(ldsp + EPI_P_OFF)};
                pg8::gemm_phase<pg8::EpiRes<false>, pg8::StaticOrder, true, true>(ldsp + RING_OFF, g, S, E); }
            if (!last) { pg8::EpiRes<false> E{F.xb, F.xb, nullptr, F.mod + (size_t)layer * 3 * MODW + 5 * DM, MODW, F.stat1, (LAS float*)(ldsp + EPI_P_OFF)};
                pg8::gemm_phase<pg8::EpiRes<false>, pg8::StaticOrder, true, true>(ldsp + RING_OFF, g, S, E); }
            else { pg8::EpiRes<true> E{F.xb, nullptr, F.out, F.mod + (size_t)layer * 3 * MODW + 5 * DM, MODW, nullptr, (LAS float*)(ldsp + EPI_P_OFF)};
                pg8::gemm_phase<pg8::EpiRes<true>, pg8::StaticOrder, true, true>(ldsp + RING_OFF, g, S, E); }
        }
#endif
        if (!last) SEAM(pb + 4);
    }
#undef IN
#undef SEAM
}

extern "C" void kernel_launch(void* const* d_in, const int* in_sizes, int n_in, void* d_out, int out_size, void* d_ws, size_t ws_size, hipStream_t stream) {
    static int grid = 0;
    if (grid == 0) {
        if (n_in != 20 || in_sizes[0] != MLAT * DM || out_size != MLAT * DM || ws_size < WS_END) {
            fprintf(stderr, "kernel_launch: unexpected shapes: n_in %d in0 %d out %d ws %zu (need >= %zu); nothing launched\n", n_in, n_in > 0 ? in_sizes[0] : -1, out_size, ws_size, (size_t)WS_END); grid = -1; return; }
        int dev = 0, cus = 0;
        if (hipGetDevice(&dev) != hipSuccess || hipDeviceGetAttribute(&cus, hipDeviceAttributeMultiprocessorCount, dev) != hipSuccess) { fprintf(stderr, "kernel_launch: device query failed\n"); grid = -1; return; }
        if (hipFuncSetAttribute((const void*)mk_fwd, hipFuncAttributeMaxDynamicSharedMemorySize, LDS_BYTES) != hipSuccess) { fprintf(stderr, "kernel_launch: hipFuncSetAttribute failed\n"); grid = -1; return; }
        int per_cu = 0;
        if (hipOccupancyMaxActiveBlocksPerMultiprocessor(&per_cu, (const void*)mk_fwd, NWAVES * 64, LDS_BYTES) != hipSuccess || per_cu < 1)
            fprintf(stderr, "kernel_launch: note: occupancy query reports %d workgroups per CU\n", per_cu);
        (void)hipGetLastError();
        grid = cus;
    }
    if (grid < 0) return;
    if (hipMemsetAsync((char*)d_ws + WS_CTL, 0, CTL_ZERO_BYTES, stream) != hipSuccess) { fprintf(stderr, "kernel_launch: memset failed\n"); return; }
    Args a{};
    for (int i = 0; i < 20; ++i) a.in[i] = (const float*)d_in[i];
    a.out = (float*)d_out; a.ws = (unsigned char*)d_ws;
#if MK_PER_PHASE
    for (int ph = 0; ph < N_PHASES; ++ph) {
        a.ph_lo = ph; a.ph_hi = ph + 1;
        hipLaunchKernelGGL(mk_fwd, dim3(grid), dim3(NWAVES * 64), LDS_BYTES, stream, a);
    }
#else
    a.ph_lo = 0; a.ph_hi = N_PHASES;
    hipLaunchKernelGGL(mk_fwd, dim3(grid), dim3(NWAVES * 64), LDS_BYTES, stream, a);
#endif
    const hipError_t le = hipPeekAtLastError();
    if (le != hipSuccess) fprintf(stderr, "kernel_launch: launch failed: %s\n", hipGetErrorName(le));
}
```

```cpp
#include <hip/hip_runtime.h>
#include <cstdio>
#include <cstdint>

template <int K> __device__ __forceinline__ float xlane_f(float v) {
    return __builtin_bit_cast(float, __builtin_amdgcn_ds_swizzle(__builtin_bit_cast(int, v), (K << 10) | 0x1F));
}
__device__ __forceinline__ float xadd32(float v) { const unsigned b = __float_as_uint(v); auto r = __builtin_amdgcn_permlane32_swap(b, b, false, false); const unsigned r0 = r[0], r1 = r[1]; return __uint_as_float(r0) + __uint_as_float(r1); }
__device__ __forceinline__ float xmax32(float v) { const unsigned b = __float_as_uint(v); auto r = __builtin_amdgcn_permlane32_swap(b, b, false, false); const unsigned r0 = r[0], r1 = r[1]; return fmaxf(__uint_as_float(r0), __uint_as_float(r1)); }
__device__ __forceinline__ float xget32(float v, bool upper) { const unsigned b = __float_as_uint(v); auto r = __builtin_amdgcn_permlane32_swap(b, b, false, false); const unsigned r0 = r[0], r1 = r[1]; return __uint_as_float(upper ? r0 : r1); }
template <int K> __device__ __forceinline__ float xadd(float v) { if constexpr (K == 32) return xadd32(v); else return v + xlane_f<K>(v); }
template <int K> __device__ __forceinline__ float xmaxk(float v) { if constexpr (K == 32) return xmax32(v); else return fmaxf(v, xlane_f<K>(v)); }

#ifndef REP_MIX
#define REP_MIX 1
#endif
#ifndef REP_ATT
#define REP_ATT 1
#endif
#ifndef REP_CONV
#define REP_CONV 1
#endif
#ifndef REP_P01
#define REP_P01 1
#endif
#ifndef REP_G0
#define REP_G0 1
#endif
#ifndef REP_G4
#define REP_G4 1
#endif
#ifndef REP_G2
#define REP_G2 1
#endif
#ifndef REP_G5
#define REP_G5 1
#endif
#ifndef REP_QK
#define REP_QK 1
#endif
#ifndef MK_PER_PHASE
#define MK_PER_PHASE 0
#endif

namespace pg8 {
#define PG8_LAS __attribute__((address_space(3)))
typedef unsigned short bf16_t;
typedef short bf16x8 __attribute__((ext_vector_type(8)));
typedef float f32x4 __attribute__((ext_vector_type(4)));
typedef unsigned u32x4 __attribute__((ext_vector_type(4)));
constexpr int BM = 256, BK = 64, HALF = 128, HTB = HALF * BK * 2, STAGE_BYTES = 8 * HTB, NXCD = 8, WGM = 8;

__host__ __device__ __forceinline__ int lds_byte(int r, int c) { return r * 128 + ((((c >> 3) ^ (r & 7)) << 4) | ((c & 7) * 2)); }
__host__ __device__ __forceinline__ void stage_rc(int b, int& R, int& C) { R = b >> 7; C = ((((b >> 4) & 7) ^ (R & 7)) << 3); }
__host__ __device__ __forceinline__ int perm32(int rho) { const int n = rho >> 4, i = rho & 15; return 8 * (i >> 2) + 4 * n + (i & 3); }

struct Unit { int pm, pn; };
struct Gemm { const bf16_t* A; const bf16_t* Bt; int M, N, K; size_t bvar; int lda = 0; size_t apanel = 0; };
__host__ __device__ __forceinline__ int variant_of(int pm) { return pm < 64 ? 0 : (pm < 128 ? 1 : 2); }

struct StaticOrder {
    int nM, nN, nwg, G, c;
    __host__ __device__ void init(int M, int N, int G_, int c_) { nM = M / BM; nN = N / BM; nwg = nM * nN; G = G_; c = c_; }
    __host__ __device__ bool next(int i, Unit& u) const {
        const long L = (long)i * G + c; if (L >= nwg) return false;
        int wgid = (int)L; { const int q = nwg / NXCD, r = nwg % NXCD, xcd = wgid % NXCD, off = wgid / NXCD; wgid = (xcd < r ? xcd * (q + 1) : r * (q + 1) + (xcd - r) * q) + off; }
        const int nig = WGM * nN, gid = wgid / nig, fm = gid * WGM, gsz = (nM - fm) < WGM ? (nM - fm) : WGM;
        u.pm = fm + ((wgid % nig) % gsz); u.pn = (wgid % nig) / gsz; return true;
    }
    __device__ __forceinline__ void a_ready(const Unit&) const {}
    __device__ __forceinline__ void done(const Unit&) const {}
};

__device__ __forceinline__ unsigned cvt_pk_bf16(float lo, float hi) { unsigned r; asm volatile("v_cvt_pk_bf16_f32 %0, %1, %2" : "=v"(r) : "v"(lo), "v"(hi)); return r; }

#define PG8_EPI_BAR() do { asm volatile("s_waitcnt lgkmcnt(0)" ::: "memory"); __builtin_amdgcn_s_barrier(); asm volatile("" ::: "memory"); } while (0)

struct EpiTabs { PG8_LAS int* US; PG8_LAS float* RS; PG8_LAS float* BT; PG8_LAS float* S1; PG8_LAS float* B1; };
template <class Sched> __device__ __forceinline__ void epi_tables(const Sched& S, const float* stat, const float* bias, int bias_vstride, int N, float eps, const EpiTabs& T) {
    int tid_ = threadIdx.x; asm volatile("" : "+v"(tid_)); const int tid = tid_;
    Unit u; S.next(0, u);
    const int v0 = variant_of(u.pm);
    int pm0 = -1, pm1 = -1, pm2 = -1, pm3 = -1, nslot = 0;
#pragma unroll 1
    for (int i = 0; i < 64; ++i) {
        if (!S.next(i, u)) break;
        int sl = 255;
        if (variant_of(u.pm) == v0) {
            if (u.pm == pm0) sl = 0; else if (u.pm == pm1) sl = 1; else if (u.pm == pm2) sl = 2; else if (u.pm == pm3) sl = 3;
            else if (nslot < 4) { sl = nslot; if (nslot == 0) pm0 = u.pm; else if (nslot == 1) pm1 = u.pm; else if (nslot == 2) pm2 = u.pm; else pm3 = u.pm; ++nslot; }
        }
        if (tid == 0) T.US[i] = sl;
    }
#pragma unroll 1
    for (int k = 0; k < nslot; ++k) { const int pm = k == 0 ? pm0 : (k == 1 ? pm1 : (k == 2 ? pm2 : pm3));
        if (tid < 256) { const f32x4 p = *(const f32x4*)(stat + (size_t)(pm * BM + tid) * 4); T.RS[k * 256 + tid] = 1.0f / sqrtf(((p[0] + p[1]) + (p[2] + p[3])) * (1.0f / 1024.0f) + eps); } }
    for (int idx = tid; idx < N / 4; idx += 512) *(PG8_LAS f32x4*)(T.BT + 4 * idx) = *(const f32x4*)(bias + (size_t)v0 * bias_vstride + 4 * idx);
    PG8_EPI_BAR();
}
__device__ __forceinline__ void epi_lookup(const EpiTabs& T, int ui, const Unit& u, const float* stat, const float* bias, int bias_vstride, float eps, const PG8_LAS float*& rsp, const PG8_LAS float*& btp) {
    const int slot = __builtin_amdgcn_readfirstlane(T.US[ui < 64 ? ui : 63]);
    if (ui < 64 && slot != 255) { rsp = T.RS + slot * 256; btp = T.BT + u.pn * BM; }
    else {
        int tid = threadIdx.x; asm volatile("" : "+v"(tid));
        if (tid < 256) { const f32x4 p = *(const f32x4*)(stat + (size_t)(u.pm * BM + tid) * 4); T.S1[tid] = 1.0f / sqrtf(((p[0] + p[1]) + (p[2] + p[3])) * (1.0f / 1024.0f) + eps); }
        else if (tid < 320) *(PG8_LAS f32x4*)(T.B1 + 4 * (tid - 256)) = *(const f32x4*)(bias + (size_t)variant_of(u.pm) * bias_vstride + u.pn * BM + 4 * (tid - 256));
        PG8_EPI_BAR();
        rsp = T.S1; btp = T.B1;
    }
}

template <int ACT> struct EpiNormAct {
    static constexpr bool PERM = true, AFTER_DRAIN = false;
    bf16_t* O; int ldc; const float* stat; const float* bias; int bias_vstride; int N; EpiTabs T; float eps; size_t opanel = 0;
    template <class Sched> __device__ __forceinline__ void prepare(const Sched& S) const { epi_tables(S, stat, bias, bias_vstride, N, eps, T); }
    __device__ __forceinline__ void operator()(const f32x4 (&acc)[2][2][4][2], const Unit& u, int wr, int wc, int fr, int fq, int ui) const {
        const PG8_LAS float* rsp; const PG8_LAS float* btp; epi_lookup(T, ui, u, stat, bias, bias_vstride, eps, rsp, btp);
        const int col0 = u.pn * BM + wc * 64 + 8 * fq;
        int bo = wc * 64 + 8 * fq, ro = wr * 64 + fr; asm volatile("" : "+v"(bo), "+v"(ro));
        f32x4 bv[2][2];
#pragma unroll
        for (int bj = 0; bj < 2; ++bj)
#pragma unroll
            for (int n = 0; n < 2; ++n) bv[bj][n] = *(const PG8_LAS f32x4*)(btp + bo + bj * 32 + 4 * n);
#pragma unroll
        for (int ai = 0; ai < 2; ++ai)
#pragma unroll
            for (int m = 0; m < 4; ++m) { const int rl = ai * HALF + wr * 64 + m * 16 + fr; const float rs = rsp[ro + ai * HALF + m * 16];
                bf16_t* rowp = O + (size_t)(u.pm * BM + rl) * ldc + (opanel ? (size_t)(col0 / ldc) * opanel + (col0 % ldc) : (size_t)col0);
#pragma unroll
                for (int bj = 0; bj < 2; ++bj) { f32x4 v0 = acc[ai][bj][m][0] * rs + bv[bj][0], v1 = acc[ai][bj][m][1] * rs + bv[bj][1];
                    if (ACT == 1) {
#pragma unroll
                        for (int e = 0; e < 4; ++e) { const float a = fmaxf(v0[e], 0.f), b = fmaxf(v1[e], 0.f); v0[e] = a * a; v1[e] = b * b; } }
                    u32x4 w; w.x = cvt_pk_bf16(v0[0], v0[1]); w.y = cvt_pk_bf16(v0[2], v0[3]); w.z = cvt_pk_bf16(v1[0], v1[1]); w.w = cvt_pk_bf16(v1[2], v1[3]);
                    *(u32x4*)(rowp + bj * 32) = w; } }
    }
};

constexpr size_t UPANEL = (size_t)33280 * 256;
struct EpiIn {
    static constexpr bool PERM = true, AFTER_DRAIN = false;
    bf16_t* U; const float* stat; const float* bias; const float* qg; const float* kg; const float* rope; EpiTabs T; PG8_LAS float* RT; float eps, qscale;
    template <class Sched> __device__ __forceinline__ void prepare(const Sched& S) const {
        int tid_ = threadIdx.x; asm volatile("" : "+v"(tid_));
        *(PG8_LAS f32x4*)(T.BT + 2048 + 4 * tid_) = *(const f32x4*)(rope + 4 * tid_);
        Unit u;
#pragma unroll 1
        for (int i = 0; i < 16; ++i) { if (!S.next(i, u)) break;
            if (tid_ < 128) RT[i * 128 + tid_] = rope[(size_t)((((u.pm * BM) & 16383) >> 6) + (tid_ >> 5)) * 32 + (tid_ & 31)]; }
        epi_tables(S, stat, bias, 2048, 2048, eps, T); }
    __device__ __forceinline__ void operator()(const f32x4 (&acc)[2][2][4][2], const Unit& u, int wr, int wc, int fr, int fq, int ui) const {
        const PG8_LAS float* S; const PG8_LAS float* btp; epi_lookup(T, ui, u, stat, bias, 2048, eps, S, btp);
        const int col0 = u.pn * BM + wc * 64 + 8 * fq;
        int bo = wc * 64 + 8 * fq, ro = wr * 64 + fr; asm volatile("" : "+v"(bo), "+v"(ro)); const PG8_LAS float* const Sr = S + ro;
        f32x4 bv[2][2];
#pragma unroll
        for (int bj = 0; bj < 2; ++bj)
#pragma unroll
            for (int n = 0; n < 2; ++n) bv[bj][n] = *(const PG8_LAS f32x4*)(btp + bo + bj * 32 + 4 * n);
        const bool head = (u.pn == 3 || u.pn == 4 || (u.pn == 5 && wc < 2));
        if (!head) {
#pragma unroll
            for (int ai = 0; ai < 2; ++ai)
#pragma unroll
                for (int m = 0; m < 4; ++m) { const int rl = ai * HALF + wr * 64 + m * 16 + fr; const float rs = Sr[ai * HALF + m * 16];
                    bf16_t* rowp = U + (size_t)u.pn * UPANEL + (size_t)(u.pm * BM + rl) * 256 + (col0 & 255);
#pragma unroll
                    for (int bj = 0; bj < 2; ++bj) { const f32x4 v0 = acc[ai][bj][m][0] * rs + bv[bj][0], v1 = acc[ai][bj][m][1] * rs + bv[bj][1];
                        u32x4 w; w.x = cvt_pk_bf16(v0[0], v0[1]); w.y = cvt_pk_bf16(v0[2], v0[3]); w.z = cvt_pk_bf16(v1[0], v1[1]); w.w = cvt_pk_bf16(v1[2], v1[3]);
                        *(u32x4*)(rowp + bj * 32) = w; } }
            return;
        }
        const bool isk = (u.pn == 5);
        const float* gsrc = (isk ? kg : qg) + 8 * fq; const float gmul = isk ? 1.0f : qscale;
        float gl[2][8];
#pragma unroll
        for (int bj = 0; bj < 2; ++bj)
#pragma unroll
            for (int j = 0; j < 8; ++j) gl[bj][j] = gsrc[32 * bj + j] * gmul;
        const bool upper = (fq & 2) != 0;
        int cto = 2048 + fr * 32 + 16 * (fq & 1), rto = (ui < 16 ? ui : 0) * 128 + wr * 32 + 16 * (fq & 1); asm volatile("" : "+v"(cto), "+v"(rto));
        const PG8_LAS float* const ctb = T.BT + cto; const PG8_LAS float* const rtb = RT + rto;
#pragma unroll
        for (int ai = 0; ai < 2; ++ai) {
            f32x4 q0, q1, q2, q3;
            if (ui < 16) { const PG8_LAS f32x4* rp = (const PG8_LAS f32x4*)(rtb + ai * 64); q0 = rp[0]; q1 = rp[1]; q2 = rp[2]; q3 = rp[3]; }
            else { const f32x4* rp = (const f32x4*)(rope + (size_t)((((u.pm * BM + ai * HALF + wr * 64) & 16383) >> 6) * 16 + 8 * (fq & 1)) * 2); q0 = rp[0]; q1 = rp[1]; q2 = rp[2]; q3 = rp[3]; }
            const float csr[8] = {q0[0], q0[2], q1[0], q1[2], q2[0], q2[2], q3[0], q3[2]}, snr[8] = {q0[1], q0[3], q1[1], q1[3], q2[1], q2[3], q3[1], q3[3]};
#pragma unroll
            for (int m = 0; m < 4; ++m) { const int rl = ai * HALF + wr * 64 + m * 16 + fr; const float rs = Sr[ai * HALF + m * 16]; const int row = u.pm * BM + rl;
                const PG8_LAS f32x4* cp = (const PG8_LAS f32x4*)(ctb + m * 16 * 32);
                const f32x4 c0 = cp[0], c1 = cp[1], c2 = cp[2], c3 = cp[3];
                const float csc[8] = {c0[0], c0[2], c1[0], c1[2], c2[0], c2[2], c3[0], c3[2]}, snc[8] = {c0[1], c0[3], c1[1], c1[3], c2[1], c2[3], c3[1], c3[3]};
                float ss = 0.f;
#pragma unroll
                for (int bj = 0; bj < 2; ++bj) { const f32x4 v0 = acc[ai][bj][m][0] * rs + bv[bj][0], v1 = acc[ai][bj][m][1] * rs + bv[bj][1];
                    ss += (v0[0] * v0[0] + v0[1] * v0[1]) + (v0[2] * v0[2] + v0[3] * v0[3]) + (v1[0] * v1[0] + v1[1] * v1[1]) + (v1[2] * v1[2] + v1[3] * v1[3]); }
                ss = xadd<16>(ss); ss = xadd<32>(ss);
                const float rn = __builtin_amdgcn_rsqf(ss * (1.0f / 64.0f) + eps);
                bf16_t* rowp = U + (size_t)u.pn * UPANEL + (size_t)row * 256 + (col0 & 255);
#pragma unroll
                for (int bj = 0; bj < 2; ++bj) { const f32x4 v0 = acc[ai][bj][m][0] * rs + bv[bj][0], v1 = acc[ai][bj][m][1] * rs + bv[bj][1];
                    float x[8] = {v0[0], v0[1], v0[2], v0[3], v1[0], v1[1], v1[2], v1[3]};
#pragma unroll
                    for (int j = 0; j < 8; ++j) { const float xv = x[j] * rn * gl[bj][j]; const float pv = xget32(xv, upper);
                        const float cs = bj ? csc[j] : csr[j], sn = bj ? snc[j] : snr[j];
                        x[j] = upper ? (pv * sn + xv * cs) : (xv * cs - pv * sn); }
                    u32x4 w; w.x = cvt_pk_bf16(x[0], x[1]); w.y = cvt_pk_bf16(x[2], x[3]); w.z = cvt_pk_bf16(x[4], x[5]); w.w = cvt_pk_bf16(x[6], x[7]);
                    *(u32x4*)(rowp + bj * 32) = w; } }
        }
    }
};

template <bool FINAL> struct EpiRes {
    static constexpr bool PERM = true, AFTER_DRAIN = false;
    const bf16_t* xb; bf16_t* xbo; float* out; const float* gate; int gate_vstride; float* stat_out; PG8_LAS float* P;
    template <class Sched> __device__ __forceinline__ void prepare(const Sched&) const {}
    __device__ __forceinline__ void operator()(const f32x4 (&acc)[2][2][4][2], const Unit& u, int wr, int wc, int fr, int fq, int) const {
        int tid_ = threadIdx.x; asm volatile("" : "+v"(tid_)); const int tid = tid_;
        const bf16_t* xbp = xb + (size_t)u.pm * BM * 1024; bf16_t* xop = xbo + (size_t)u.pm * BM * 1024;
        float* op = out + (size_t)u.pm * BM * 1024;
        const int col0 = u.pn * BM + wc * 64 + 8 * fq;
        int lo_ = (wr * 64 + fr) * 1024 + wc * 64 + 8 * fq; asm volatile("" : "+v"(lo_));
        const unsigned lo = (unsigned)lo_ + (unsigned)(u.pn * BM);
        const float* gp = gate + (size_t)variant_of(u.pm) * gate_vstride + col0;
        f32x4 gv[2][2];
#pragma unroll
        for (int bj = 0; bj < 2; ++bj)
#pragma unroll
            for (int n = 0; n < 2; ++n) gv[bj][n] = *(const f32x4*)(gp + bj * 32 + 4 * n);
#pragma unroll
        for (int ai = 0; ai < 2; ++ai) {
            u32x4 xr[4][2];
#pragma unroll
            for (int m = 0; m < 4; ++m)
#pragma unroll
                for (int bj = 0; bj < 2; ++bj) xr[m][bj] = *(const u32x4*)(xbp + (lo + (unsigned)((ai * HALF + m * 16) * 1024 + bj * 32)));
#pragma unroll
            for (int m = 0; m < 4; ++m) { const int rl = ai * HALF + wr * 64 + m * 16 + fr; const unsigned off = lo + (unsigned)((ai * HALF + m * 16) * 1024); float ss = 0.f;
#pragma unroll
                for (int bj = 0; bj < 2; ++bj) {
                    const u32x4 xi = xr[m][bj];
                    const f32x4 a0 = (f32x4){__uint_as_float(xi.x << 16), __uint_as_float(xi.x & 0xffff0000u), __uint_as_float(xi.y << 16), __uint_as_float(xi.y & 0xffff0000u)};
                    const f32x4 a1 = (f32x4){__uint_as_float(xi.z << 16), __uint_as_float(xi.z & 0xffff0000u), __uint_as_float(xi.w << 16), __uint_as_float(xi.w & 0xffff0000u)};
                    const f32x4 o0 = a0 + gv[bj][0] * acc[ai][bj][m][0], o1 = a1 + gv[bj][1] * acc[ai][bj][m][1];
                    if (FINAL) { *(f32x4*)(op + off + bj * 32) = o0; *(f32x4*)(op + off + bj * 32 + 4) = o1; }
                    else {
                        u32x4 w; w.x = cvt_pk_bf16(o0[0], o0[1]); w.y = cvt_pk_bf16(o0[2], o0[3]); w.z = cvt_pk_bf16(o1[0], o1[1]); w.w = cvt_pk_bf16(o1[2], o1[3]);
                        *(u32x4*)(xop + off + bj * 32) = w;
                        ss += (o0[0] * o0[0] + o0[1] * o0[1]) + (o0[2] * o0[2] + o0[3] * o0[3]) + (o1[0] * o1[0] + o1[1] * o1[1]) + (o1[2] * o1[2] + o1[3] * o1[3]); } }
                if (!FINAL) { ss = xadd<16>(ss); ss = xadd<32>(ss); if (fq == 0) P[rl * 4 + wc] = ss; } }
        }
        if (!FINAL) {
            PG8_EPI_BAR();
            if (tid < 256) { const f32x4 p = *(const PG8_LAS f32x4*)(P + tid * 4); stat_out[(size_t)(u.pm * BM + tid) * 4 + u.pn] = (p[0] + p[1]) + (p[2] + p[3]); }
        }
    }
};

template <class Epi, class Sched, bool ALIGN_EPI = false, bool SP2 = false>
__device__ __forceinline__ void gemm_phase(PG8_LAS unsigned char* lds, const Gemm g, const Sched& S, const Epi& E) {
    int tid_ = threadIdx.x; asm volatile("" : "+v"(tid_));
    const int tid = tid_, wid = __builtin_amdgcn_readfirstlane(tid >> 6), lane = tid & 63, wr = wid >> 2, wc = wid & 3, fr = lane & 15, fq = lane >> 4;
    const int K = g.K, nt = K / BK, lda = g.lda ? g.lda : g.K, ktpp = g.apanel ? lda / BK : nt; const size_t apan = g.apanel;
    unsigned voffA[2], voffB[2];
#pragma unroll
    for (int i = 0; i < 2; ++i) { int R, C; stage_rc(tid * 16 + i * 8192, R, C); const int Rb = Epi::PERM ? (64 * (R >> 5) + perm32(R & 31)) : R;
        voffA[i] = (unsigned)(R * lda + C) * 2u; voffB[i] = (unsigned)(Rb * K + C) * 2u; }
    const size_t kstep = (size_t)(BK * 2);
    const size_t hstepB = (size_t)(Epi::PERM ? 32 : HALF) * K * 2, hstepA = (size_t)HALF * lda * 2;
    const size_t tstep = (size_t)BM * K * 2, tstepA = 2 * hstepA;
    const unsigned ldsw = (unsigned)wid * 1024u;
    const int aoff = lds_byte(wr * 64 + fr, fq * 8), boff = lds_byte(wc * 32 + fr, fq * 8);
    const int aoff1 = aoff ^ 64, boff1 = boff ^ 64;
#define PG8_SA(b, h) (((b) * 2 + (h)) * HTB)
#define PG8_SB(b, h) ((4 + (b) * 2 + (h)) * HTB)
#define PG8_STAGE(bufoff, gbase, voff) do { _Pragma("unroll") for (int _i = 0; _i < 2; ++_i) \
        __builtin_amdgcn_global_load_lds((const unsigned*)((const char*)(gbase) + (voff)[_i]), (PG8_LAS unsigned*)(lds + (bufoff) + ldsw + _i * 8192), 16, 0, 0); } while (0)
#define PG8_LDA(dst, b, h) do { _Pragma("unroll") for (int m = 0; m < 4; ++m) _Pragma("unroll") for (int k = 0; k < 2; ++k) dst[m][k] = *(const PG8_LAS bf16x8*)(lds + PG8_SA(b, h) + (k ? aoff1 : aoff) + m * 2048); } while (0)
#define PG8_LDB(dst, b, h) do { _Pragma("unroll") for (int n = 0; n < 2; ++n) _Pragma("unroll") for (int k = 0; k < 2; ++k) dst[n][k] = *(const PG8_LAS bf16x8*)(lds + PG8_SB(b, h) + (k ? boff1 : boff) + n * 2048); } while (0)
#define PG8_MMA(ai, bj, At, Bt) do { __builtin_amdgcn_s_setprio(1); _Pragma("unroll") for (int m = 0; m < 4; ++m) _Pragma("unroll") for (int n = 0; n < 2; ++n) _Pragma("unroll") for (int k = 0; k < 2; ++k) \
        acc[ai][bj][m][n] = __builtin_amdgcn_mfma_f32_16x16x32_bf16(Bt[n][k], At[m][k], acc[ai][bj][m][n], 0, 0, 0); __builtin_amdgcn_s_setprio(0); } while (0)
#define PG8_WAIT_V(n) asm volatile("s_waitcnt vmcnt(" #n ")" ::: "memory")
#define PG8_WAIT_L(n) asm volatile("s_waitcnt lgkmcnt(" #n ")" ::: "memory")
#define PG8_BAR __builtin_amdgcn_s_barrier()
#define PG8_SCHED __builtin_amdgcn_sched_barrier(0)
    Unit cur, nxt; int ui = 0;
    if (!S.next(0, cur)) return;
    E.prepare(S);
    f32x4 acc[2][2][4][2];
#pragma unroll
    for (int a = 0; a < 2; ++a)
#pragma unroll
        for (int b = 0; b < 2; ++b)
#pragma unroll
            for (int m = 0; m < 4; ++m)
#pragma unroll
                for (int n = 0; n < 2; ++n) acc[a][b][m][n] = (f32x4){0.f, 0.f, 0.f, 0.f};
    bf16x8 At[4][2], B0[2][2], B1[2][2];
    const char* cA = (const char*)g.A + (size_t)cur.pm * tstepA; const char* cB = (const char*)g.Bt + (size_t)variant_of(cur.pm) * g.bvar + (size_t)cur.pn * tstep;
    S.a_ready(cur);
    if constexpr (SP2) {
        PG8_STAGE(PG8_SB(0, 0), cB, voffB); PG8_STAGE(PG8_SB(0, 1), cB + hstepB, voffB); PG8_STAGE(PG8_SA(0, 0), cA, voffA); PG8_STAGE(PG8_SA(0, 1), cA + hstepA, voffA);
        if (wr == 1) PG8_BAR;
        PG8_WAIT_V(2); PG8_BAR;
        PG8_STAGE(PG8_SB(1, 0), cB + kstep, voffB); PG8_STAGE(PG8_SA(1, 0), cA + kstep, voffA); PG8_STAGE(PG8_SB(1, 1), cB + hstepB + kstep, voffB);
        PG8_WAIT_V(6); PG8_BAR;
    } else {
        PG8_STAGE(PG8_SB(0, 0), cB, voffB); PG8_STAGE(PG8_SA(0, 0), cA, voffA); PG8_STAGE(PG8_SB(0, 1), cB + hstepB, voffB); PG8_STAGE(PG8_SA(0, 1), cA + hstepA, voffA);
        if (wr == 1) PG8_BAR;
        PG8_WAIT_V(4); PG8_BAR;
        PG8_STAGE(PG8_SB(1, 0), cB + kstep, voffB); PG8_STAGE(PG8_SA(1, 0), cA + kstep, voffA); PG8_STAGE(PG8_SB(1, 1), cB + hstepB + kstep, voffB);
        PG8_WAIT_V(6); PG8_BAR;
    }
    for (;;) {
        const bool has_next = S.next(ui + 1, nxt);
        const char* nA = has_next ? (const char*)g.A + (size_t)nxt.pm * tstepA : cA;
        const char* nB = has_next ? (const char*)g.Bt + (size_t)variant_of(nxt.pm) * g.bvar + (size_t)nxt.pn * tstep : cB;
        for (int t = 0; t < nt; t += 2) {
            const bool last = (t == nt - 2);
            const int t2 = t + 2; const size_t ak0 = (size_t)(t / ktpp) * apan + (size_t)(t % ktpp) * kstep, ak2 = (size_t)(t2 / ktpp) * apan + (size_t)(t2 % ktpp) * kstep;
            const char* a1 = cA + ak0 + kstep;
            const char* a2 = last ? nA : cA + ak2; const char* b2 = last ? nB : cB + (size_t)(t + 2) * kstep;
            const char* a3 = a2 + kstep; const char* b3 = b2 + kstep;
            if (last && has_next) S.a_ready(nxt);
            if constexpr (SP2) {
            PG8_LDB(B0, 0, 0); PG8_LDB(B1, 0, 1); PG8_SCHED; PG8_LDA(At, 0, 0); PG8_STAGE(PG8_SA(1, 1), a1 + hstepA, voffA);
            PG8_WAIT_V(8); PG8_WAIT_L(0); PG8_BAR; PG8_MMA(0, 0, At, B0); PG8_MMA(0, 1, At, B1); PG8_BAR; PG8_SCHED;
            PG8_LDA(At, 0, 1); PG8_STAGE(PG8_SB(0, 0), b2, voffB); PG8_STAGE(PG8_SB(0, 1), b2 + hstepB, voffB); PG8_STAGE(PG8_SA(0, 0), a2, voffA);
            PG8_WAIT_V(8); PG8_WAIT_L(0); PG8_BAR; PG8_MMA(1, 0, At, B0); PG8_MMA(1, 1, At, B1); PG8_BAR; PG8_SCHED;
            PG8_LDB(B0, 1, 0); PG8_LDB(B1, 1, 1); PG8_SCHED; PG8_LDA(At, 1, 0); PG8_STAGE(PG8_SA(0, 1), a2 + hstepA, voffA);
            PG8_WAIT_V(8); PG8_WAIT_L(0); PG8_BAR; PG8_MMA(0, 0, At, B0); PG8_MMA(0, 1, At, B1); PG8_BAR; PG8_SCHED;
            PG8_LDA(At, 1, 1); PG8_STAGE(PG8_SB(1, 0), b3, voffB); PG8_STAGE(PG8_SB(1, 1), b3 + hstepB, voffB); PG8_STAGE(PG8_SA(1, 0), a3, voffA);
            PG8_WAIT_V(8); PG8_WAIT_L(0); PG8_BAR; PG8_MMA(1, 0, At, B0); PG8_MMA(1, 1, At, B1); PG8_BAR; PG8_SCHED;
            } else {
            PG8_LDB(B0, 0, 0); PG8_SCHED; PG8_LDA(At, 0, 0); PG8_STAGE(PG8_SA(1, 1), a1 + hstepA, voffA);
            PG8_WAIT_L(8); PG8_BAR; PG8_WAIT_L(0); PG8_MMA(0, 0, At, B0); PG8_BAR; PG8_SCHED;
            PG8_LDB(B1, 0, 1); PG8_STAGE(PG8_SB(0, 0), b2, voffB);
            PG8_BAR; PG8_WAIT_L(0); PG8_MMA(0, 1, At, B1); PG8_BAR;
            PG8_LDA(At, 0, 1); PG8_STAGE(PG8_SA(0, 0), a2, voffA);
            PG8_BAR; PG8_WAIT_L(0); PG8_MMA(1, 0, At, B0); PG8_BAR; PG8_SCHED;
            PG8_STAGE(PG8_SB(0, 1), b2 + hstepB, voffB);
            PG8_WAIT_V(6); PG8_BAR; PG8_MMA(1, 1, At, B1); PG8_BAR;
            PG8_LDB(B0, 1, 0); PG8_SCHED; PG8_LDA(At, 1, 0); PG8_STAGE(PG8_SA(0, 1), a2 + hstepA, voffA);
            PG8_WAIT_L(8); PG8_BAR; PG8_WAIT_L(0); PG8_MMA(0, 0, At, B0); PG8_BAR; PG8_SCHED;
            PG8_LDB(B1, 1, 1); PG8_STAGE(PG8_SB(1, 0), b3, voffB);
            PG8_BAR; PG8_WAIT_L(0); PG8_MMA(0, 1, At, B1); PG8_BAR;
            PG8_LDA(At, 1, 1); PG8_STAGE(PG8_SA(1, 0), a3, voffA);
            PG8_BAR; PG8_WAIT_L(0); PG8_MMA(1, 0, At, B0); PG8_BAR; PG8_SCHED;
            PG8_STAGE(PG8_SB(1, 1), b3 + hstepB, voffB);
            PG8_WAIT_V(6); PG8_BAR; PG8_MMA(1, 1, At, B1); PG8_BAR;
            }
        }
        if constexpr (ALIGN_EPI) { if (wr == 0) PG8_BAR; }
        if constexpr (!Epi::AFTER_DRAIN) { E(acc, cur, wr, wc, fr, fq, ui); S.done(cur); }
        if (!has_next) break;
#pragma unroll
        for (int a = 0; a < 2; ++a)
#pragma unroll
            for (int b = 0; b < 2; ++b)
#pragma unroll
                for (int m = 0; m < 4; ++m)
#pragma unroll
                    for (int n = 0; n < 2; ++n) acc[a][b][m][n] = (f32x4){0.f, 0.f, 0.f, 0.f};
        cur = nxt; cA = nA; cB = nB; ++ui;
        if constexpr (ALIGN_EPI) { if (wr == 1) PG8_BAR; }
    }
    PG8_WAIT_V(0);
    if constexpr (!ALIGN_EPI) { if (wr == 0) PG8_BAR; }
    PG8_BAR;
#undef PG8_SA
#undef PG8_SB
#undef PG8_STAGE
#undef PG8_LDA
#undef PG8_LDB
#undef PG8_MMA
#undef PG8_WAIT_V
#undef PG8_WAIT_L
#undef PG8_BAR
#undef PG8_SCHED
}
}

constexpr int NWAVES = 8;
constexpr int DM = 1024, DIN = 2048, DFF = 4096, SEQ = 16384, NBATCH = 2, CTXL = 256, NLAYER = 2;
constexpr int MLAT = NBATCH * SEQ, MCTX = NBATCH * CTXL, MTOT = MLAT + MCTX;
constexpr int OFF_Q = 768, OFF_K = 1280, OFF_V = 1408, OFF_C = 1536;
constexpr size_t UPS = (size_t)MTOT * 256;
static_assert(UPS == pg8::UPANEL, "U panel size");
__host__ __device__ __forceinline__ size_t u_idx(int row, int col) { return (size_t)(col >> 8) * UPS + (size_t)row * 256 + (size_t)(col & 255); }
constexpr int NHEAD = 8, NKV = 2, HD = 64;
constexpr float EPS = 1e-6f;
constexpr int MODW = 6 * DM;
constexpr int KSPLIT = 8;
constexpr float QSCALE = 0.125f * 1.4426950408889634f;

constexpr size_t MiB = 1u << 20;
constexpr size_t WS_CTL = 0, CTL_ZERO_BYTES = 32768;
constexpr size_t WS_MODP = 1 * MiB;
constexpr size_t WS_MOD = 3 * MiB;
constexpr size_t WS_BIAS1 = 3 * MiB + 256 * 1024;
constexpr size_t WS_BIAS2 = 3 * MiB + 512 * 1024;
constexpr size_t WS_ROPE = 3 * MiB + 768 * 1024;
constexpr size_t WS_STAT1 = 4 * MiB;
constexpr size_t WS_STAT2 = 5 * MiB;
constexpr size_t WS_STATC1 = 5 * MiB + 640 * 1024;
constexpr size_t WS_STATC2 = 5 * MiB + 704 * 1024;
constexpr size_t WS_XC = 6 * MiB;
constexpr size_t WS_WIN = 8 * MiB;
constexpr size_t WS_WOUT = 32 * MiB;
constexpr size_t WS_W1 = 36 * MiB;
constexpr size_t WS_W2 = 84 * MiB;
constexpr size_t WS_XB = 100 * MiB;
constexpr size_t WS_U = 165 * MiB;
constexpr size_t WS_Y = 295 * MiB;
constexpr size_t WS_H = 165 * MiB;
constexpr size_t WS_END = 425 * MiB;
constexpr size_t WS_SCRATCH = 425 * MiB;
static_assert(WS_H + (size_t)MTOT * DFF * 2 <= WS_END && WS_Y + (size_t)MTOT * DM * 2 <= WS_END && WS_U + (size_t)MTOT * DIN * 2 <= WS_Y && WS_XB + (size_t)MTOT * DM * 2 <= WS_U, "ws map");
constexpr int CW_BAR = 4096;
static_assert((CW_BAR + 3456) * 4 <= (int)CTL_ZERO_BYTES, "barrier words inside the per-call memset");

constexpr int RING_OFF = 0, RING_BYTES = 131072;
constexpr int LDSCTL_OFF = RING_BYTES, MISC_OFF = LDSCTL_OFF + 320;
constexpr int EPI_US_OFF = RING_BYTES + 512;
constexpr int EPI_S_OFF = RING_BYTES + 1024;
constexpr int EPI_P_OFF = RING_BYTES + 2048;
constexpr int EPI_RS_OFF = RING_BYTES + 10240;
constexpr int EPI_BT_OFF = RING_BYTES + 14336;
constexpr int EPI_B1_OFF = RING_BYTES + 30720;
constexpr int EPI_RT_OFF = RING_BYTES + 31744;
constexpr int LDS_BYTES = RING_BYTES + 32256;
static_assert(EPI_P_OFF + 8192 <= EPI_RS_OFF && LDS_BYTES <= 163840, "LDS map");

#define GAS __attribute__((address_space(1)))
#define LAS __attribute__((address_space(3)))
typedef unsigned short bf16;
typedef unsigned v4u __attribute__((ext_vector_type(4)));
typedef unsigned v2u __attribute__((ext_vector_type(2)));
typedef float f32x4 __attribute__((ext_vector_type(4)));
typedef GAS unsigned gu32;
#define RLX_AGENT __ATOMIC_RELAXED, __HIP_MEMORY_SCOPE_AGENT
#define LDS_WAIT() asm volatile("s_waitcnt lgkmcnt(0)" ::: "memory")
typedef float f32x2_t __attribute__((ext_vector_type(2)));
typedef __bf16 bf16x2_t __attribute__((ext_vector_type(2)));
__device__ __forceinline__ unsigned pk2(float lo, float hi) { f32x2_t v = {lo, hi}; bf16x2_t b = __builtin_convertvector(v, bf16x2_t); return __builtin_bit_cast(unsigned, b); }
__device__ __forceinline__ unsigned f2bf(float f) { return pk2(f, 0.f) & 0xffffu; }
__device__ __forceinline__ float bflo(unsigned w) { return __builtin_bit_cast(float, w << 16); }
__device__ __forceinline__ float bfhi(unsigned w) { return __builtin_bit_cast(float, w & 0xffff0000u); }
__device__ __forceinline__ float bf1(bf16 h) { return __builtin_bit_cast(float, (unsigned)h << 16); }
__device__ __forceinline__ float sigmoidf_(float v) { return __builtin_amdgcn_rcpf(1.0f + __expf(-v)); }

#define XB_TMO      128
#define XB_XCNT(j)  (256  + 64 * (j))
#define XB_XSUB(j)  (1280 + 64 * (j))
#define XB_XGEN(j)  (2304 + 64 * (j))
#define XB_TOP      3328
#define XB_TOPGEN   3392
#define XCD_BAR_WORDS 3456
#define XB_SPIN_CAP (1u << 18)
__device__ __forceinline__ unsigned xb_ld(unsigned* p)              { return __hip_atomic_load(p, __ATOMIC_RELAXED, __HIP_MEMORY_SCOPE_AGENT); }
__device__ __forceinline__ unsigned xb_add(unsigned* p, unsigned v) { return __hip_atomic_fetch_add(p, v, __ATOMIC_RELAXED, __HIP_MEMORY_SCOPE_AGENT); }
__device__ __forceinline__ unsigned xb_xcc_id() { return (unsigned)__builtin_amdgcn_s_getreg((3 << 11) | 20) & 0xFu; }
#define XB_SPIN(cond, bar) do { unsigned _sp = 0; while (cond) { __builtin_amdgcn_s_sleep(1); \
    if ((++_sp & 255u) == 0u) { if (xb_ld(&(bar)[XB_TMO])) break; if (_sp > XB_SPIN_CAP) { atomicAdd(&(bar)[XB_TMO], 1u); break; } } } } while (0)
struct XcdBarrier { unsigned* bar; unsigned x; volatile LAS unsigned* st; };
__device__ __forceinline__ XcdBarrier xcd_barrier_post(unsigned* bar, volatile LAS unsigned* st) {
    XcdBarrier b; b.bar = bar; b.x = xb_xcc_id(); b.st = st;
    if (threadIdx.x == 0) (void)xb_add(&bar[XB_XCNT(b.x)], 1u);
    return b;
}
__device__ __forceinline__ void xcd_barrier_complete(unsigned* bar, unsigned x, unsigned& nloc, unsigned& nx) {
    const unsigned G = gridDim.x * gridDim.y * gridDim.z;
    unsigned sum, cnt, mine, sp = 0u;
    for (;;) {
        sum = 0u; cnt = 0u; mine = 0u;
#pragma unroll
        for (unsigned j = 0; j < 16; ++j) { const unsigned c = xb_ld(&bar[XB_XCNT(j)]); sum += c; cnt += (c > 0u) ? 1u : 0u; mine = (j == x) ? c : mine; }
        if (sum == G) break;
        __builtin_amdgcn_s_sleep(1);
        if ((++sp & 255u) == 0u) { if (xb_ld(&bar[XB_TMO])) break; if (sp > XB_SPIN_CAP) { atomicAdd(&bar[XB_TMO], 1u); break; } }
    }
    nloc = mine > 0u ? mine : 1u; nx = cnt > 0u ? cnt : 1u;
}
__device__ __forceinline__ void xcd_barrier(const XcdBarrier& b) {
    asm volatile("s_waitcnt vmcnt(0)" ::: "memory");
    __syncthreads();
    if (threadIdx.x == 0) {
        unsigned* bar = b.bar;
        __builtin_amdgcn_s_waitcnt(0);
        unsigned nloc = b.st[0], nx = b.st[1];
        if (nloc == 0u) { xcd_barrier_complete(bar, b.x, nloc, nx); b.st[0] = nloc; b.st[1] = nx; }
        const unsigned old = xb_add(&bar[XB_XSUB(b.x)], 1u);
        const unsigned gen = old / nloc;
        if (old + 1u == (gen + 1u) * nloc) {
            __builtin_amdgcn_fence(__ATOMIC_RELEASE, "agent");
            asm volatile("s_waitcnt vmcnt(0)" ::: "memory");
            const unsigned og = xb_add(&bar[XB_TOP], 1u);
            const unsigned tg = og / nx;
            if (og + 1u == (tg + 1u) * nx) xb_add(&bar[XB_TOPGEN], 1u);
            else XB_SPIN(xb_ld(&bar[XB_TOPGEN]) == tg, bar);
            __builtin_amdgcn_fence(__ATOMIC_ACQUIRE, "agent");
            xb_add(&bar[XB_XGEN(b.x)], 1u);
            asm volatile("s_waitcnt vmcnt(0)" ::: "memory");
        } else {
            XB_SPIN(xb_ld(&bar[XB_XGEN(b.x)]) == gen, bar);
            __builtin_amdgcn_fence(__ATOMIC_ACQUIRE, "agent");
            asm volatile("s_waitcnt vmcnt(0)" ::: "memory");
        }
    }
    __syncthreads();
}

struct Args {
    const float* in[20]; float* out; unsigned char* ws; int ph_lo, ph_hi;
};
struct Frame {
    LAS unsigned char* lds;
    int tid, lane, wave, vcu, G;
    const float *x, *c, *ctx, *c_ctx, *w_mod, *b_mod, *norm1_g, *w_in, *conv_a_w, *q_norm_g, *k_norm_g, *attn_sink, *conv_c_w, *conv_c_b, *ln_c_g, *ln_c_b, *w_out, *norm2_g, *w_mlp1, *w_mlp2;
    float* out;
    float *modp, *mod, *bias1, *bias2, *rope, *stat1, *stat2, *statc1, *statc2, *xc;
    bf16 *win_t, *wout_t, *w1_t, *w2_t, *xb, *u, *y, *h;
};

__device__ __forceinline__ float wave_sum(float v) { v = xadd<1>(v); v = xadd<2>(v); v = xadd<4>(v); v = xadd<8>(v); v = xadd<16>(v); return xadd<32>(v); }

__device__ __forceinline__ void sincos_d(double x, double& s, double& c) {
    const double TWO_PI = 6.283185307179586476925286766559;
    const double k = rint(x / TWO_PI); const double r = x - k * TWO_PI, r2 = r * r;
    double ts = r, tc = 1.0; s = r; c = 1.0;
#pragma unroll 1
    for (int i = 1; i <= 18; ++i) { tc *= -r2 / (double)((2 * i - 1) * (2 * i)); c += tc; ts *= -r2 / (double)((2 * i) * (2 * i + 1)); s += ts; }
}
__device__ __forceinline__ void p0_phase(Frame& F) {
    LAS float* sl = (LAS float*)(F.lds + RING_OFF);
    for (int item = blockIdx.x; item < NLAYER * KSPLIT * 12; item += F.G) {
        const int l = item / (KSPLIT * 12), rr = item % (KSPLIT * 12), ks = rr / 12, cc = rr % 12, n = cc * 512 + F.tid;
        __syncthreads();
        if (F.tid < 384) { const int r = F.tid >> 7, kk = F.tid & 127; const float cv = (r < 2) ? F.c[r * DM + ks * 128 + kk] : F.c_ctx[ks * 128 + kk]; sl[F.tid] = cv / (1.0f + expf(-cv)); }
        __syncthreads();
        const float* W = F.w_mod + (size_t)l * DM * MODW + (size_t)(ks * 128) * MODW + n;
        float a0 = 0.f, a1 = 0.f, a2 = 0.f;
#pragma unroll 8
        for (int kk = 0; kk < 128; ++kk) { const float w = W[(size_t)kk * MODW]; a0 += sl[kk] * w; a1 += sl[128 + kk] * w; a2 += sl[256 + kk] * w; }
        float* o = F.modp + ((size_t)(ks * NLAYER + l) * 3) * MODW + n;
        o[0] = a0; o[MODW] = a1; o[2 * MODW] = a2;
    }
    __syncthreads();
    const int gw = F.vcu * NWAVES + F.wave, NGW = F.G * NWAVES;
    for (int row = gw; row < MTOT; row += NGW) {
        const float* src = (row < MLAT) ? F.x + (size_t)row * DM : F.ctx + (size_t)(row - MLAT) * DM;
        const f32x4* xr = (const f32x4*)src + F.lane;
        f32x4 v[4]; float q[4];
#pragma unroll
        for (int j = 0; j < 4; ++j) { v[j] = xr[64 * j]; q[j] = wave_sum((v[j].x * v[j].x + v[j].y * v[j].y) + (v[j].z * v[j].z + v[j].w * v[j].w)); }
        unsigned long long* o8 = (unsigned long long*)(F.xb + (size_t)row * DM) + F.lane;
#pragma unroll
        for (int j = 0; j < 4; ++j) o8[64 * j] = (unsigned long long)pk2(v[j].x, v[j].y) | ((unsigned long long)pk2(v[j].z, v[j].w) << 32);
        if (F.lane == 0) *(f32x4*)(F.stat1 + (size_t)row * 4) = (f32x4){q[0], q[1], q[2], q[3]};
        if (row >= MLAT) {
#pragma unroll
            for (int j = 0; j < 4; ++j) { float p = (v[j].x * v[j].x + v[j].y * v[j].y) + (v[j].z * v[j].z + v[j].w * v[j].w);
                p = xadd<1>(p); p = xadd<2>(p); p = xadd<4>(p); p = xadd<8>(p);
                if ((F.lane & 15) == 0) F.statc1[(size_t)(row - MLAT) * 16 + 4 * j + (F.lane >> 4)] = p; }
        }
    }
    if (blockIdx.x == F.G - 1) {
        const float inv_freq[16] = {1.0f, 0.5623413324356079f, 0.3162277638912201f, 0.17782793939113617f, 0.10000000149011612f, 0.05623413249850273f, 0.03162277489900589f, 0.017782794311642647f,
                                    0.009999999776482582f, 0.005623413249850273f, 0.003162277629598975f, 0.0017782794311642647f, 0.0010000000474974513f, 0.000562341301701963f, 0.0003162277571391314f, 0.00017782794020604342f};
        for (int idx = F.tid; idx < 256 * 16; idx += NWAVES * 64) {
            const int pos = idx >> 4, i = idx & 15;
            float fr = 1.0f;
#pragma unroll
            for (int j = 0; j < 16; ++j) fr = (i == j) ? inv_freq[j] : fr;
            const float ang = (float)pos * fr; double s, c; sincos_d((double)ang, s, c);
            F.rope[idx * 2] = (float)c; F.rope[idx * 2 + 1] = (float)s;
        }
    }
}

__device__ __forceinline__ void p1_transpose_item(Frame& F, const float* W, int K, int N, bf16* WT, size_t vstride, int nvar, const float* gvec, int layer, int scoff, LAS float* scr, int item) {
    const int lane = F.lane;
    const int nblk = N / 32, kb = item / nblk, nb = item % nblk, k0 = 64 * kb, n0 = 32 * nb;
    LAS float* gsl = scr + 64 * 33;
#pragma unroll 8
    for (int i = 0; i < 32; ++i) { const int kk = 2 * i + (lane >> 5); scr[kk * 33 + (lane & 31)] = W[(size_t)(k0 + kk) * N + n0 + (lane & 31)]; }
    if (gvec) {
        const float g = gvec[k0 + lane];
#pragma unroll
        for (int v = 0; v < 3; ++v) { float s = F.b_mod[layer * MODW + scoff + k0 + lane];
#pragma unroll
            for (int p = 0; p < KSPLIT; ++p) s += F.modp[((size_t)(p * NLAYER + layer) * 3 + v) * MODW + scoff + k0 + lane];
            gsl[v * 64 + lane] = g * (1.0f + s); }
    }
    LDS_WAIT(); asm volatile("" ::: "memory");
    const int c = lane & 7;
    for (int v = 0; v < nvar; ++v) {
        float sc[8];
#pragma unroll
        for (int e = 0; e < 8; ++e) sc[e] = gvec ? gsl[v * 64 + 8 * c + e] : 1.0f;
#pragma unroll
        for (int j = 0; j < 4; ++j) { const int n = (lane >> 3) + 8 * j; const LAS float* s = scr + (8 * c) * 33 + n;
            v4u o; o.x = pk2(s[0 * 33] * sc[0], s[1 * 33] * sc[1]); o.y = pk2(s[2 * 33] * sc[2], s[3 * 33] * sc[3]); o.z = pk2(s[4 * 33] * sc[4], s[5 * 33] * sc[5]); o.w = pk2(s[6 * 33] * sc[6], s[7 * 33] * sc[7]);
            *(v4u*)(WT + (size_t)v * vstride + (size_t)(n0 + n) * K + k0 + 8 * c) = o; }
    }
    LDS_WAIT(); asm volatile("" ::: "memory");
}
__device__ __forceinline__ void p1_phase(Frame& F) {
    {
        LAS float* shl = (LAS float*)(F.lds + RING_OFF);
        LAS float* red = shl + 3 * 1024;
        for (int item = blockIdx.x; item < NLAYER * 96; item += F.G) {
            const int l = item / 96, j = item % 96; const bool is_in = j < 32;
            const int N = is_in ? DIN : DFF, c0 = (is_in ? j : j - 32) * 64, shoff = is_in ? 0 : 3 * DM;
            const float* W = (is_in ? F.w_in + (size_t)l * DM * DIN : F.w_mlp1 + (size_t)l * DM * DFF);
            __syncthreads();
            for (int idx = F.tid; idx < 3 * 1024; idx += NWAVES * 64) { const int v = idx >> 10, k = idx & 1023; float s = F.b_mod[l * MODW + shoff + k];
#pragma unroll
                for (int p = 0; p < KSPLIT; ++p) s += F.modp[((size_t)(p * NLAYER + l) * 3 + v) * MODW + shoff + k];
                shl[idx] = s; }
            __syncthreads();
            const int col = F.tid & 63, kg = F.tid >> 6;
            const float* Wp = W + (size_t)(kg * 128) * N + c0 + col;
            float a0 = 0.f, a1 = 0.f, a2 = 0.f;
#pragma unroll 8
            for (int kk = 0; kk < 128; ++kk) { const float w = Wp[(size_t)kk * N]; const int k = kg * 128 + kk; a0 += shl[k] * w; a1 += shl[1024 + k] * w; a2 += shl[2048 + k] * w; }
            red[(kg * 3 + 0) * 64 + col] = a0; red[(kg * 3 + 1) * 64 + col] = a1; red[(kg * 3 + 2) * 64 + col] = a2;
            __syncthreads();
            if (F.tid < 192) { const int v = F.tid >> 6, cc = F.tid & 63; float s = 0.f;
#pragma unroll
                for (int g = 0; g < 8; ++g) s += red[(g * 3 + v) * 64 + cc];
                float* dst = is_in ? F.bias1 + ((size_t)l * 3 + v) * DIN : F.bias2 + ((size_t)l * 3 + v) * DFF;
                dst[c0 + cc] = s; }
        }
        __syncthreads();
    }
    for (int idx = blockIdx.x * (NWAVES * 64) + F.tid; idx < NLAYER * 3 * MODW; idx += F.G * NWAVES * 64) {
        const int l = idx / (3 * MODW), rem = idx % (3 * MODW), v = rem / MODW, n = rem % MODW;
        float s = F.b_mod[l * MODW + n];
#pragma unroll
        for (int p = 0; p < KSPLIT; ++p) s += F.modp[((size_t)(p * NLAYER + l) * 3 + v) * MODW + n];
        F.mod[idx] = s;
    }
    LAS float* scr = (LAS float*)(F.lds + RING_OFF + F.wave * 16384);
    const int gw = F.vcu * NWAVES + F.wave, NGW = F.G * NWAVES;
    constexpr int I_IN = (DM / 64) * (DIN / 32), I_1 = (DM / 64) * (DFF / 32), I_O = (DM / 64) * (DM / 32), I_2 = (DFF / 64) * (DM / 32), I_L = I_IN + I_1 + I_O + I_2;
    for (int it = gw; it < NLAYER * I_L; it += NGW) {
        const int l = it / I_L; int r = it % I_L;
        if (r < I_IN) { p1_transpose_item(F, F.w_in + (size_t)l * DM * DIN, DM, DIN, F.win_t + (size_t)l * 3 * DIN * DM, (size_t)DIN * DM, 3, F.norm1_g + l * DM, l, 1 * DM, scr, r); continue; } r -= I_IN;
        if (r < I_1) { p1_transpose_item(F, F.w_mlp1 + (size_t)l * DM * DFF, DM, DFF, F.w1_t + (size_t)l * 3 * DFF * DM, (size_t)DFF * DM, 3, F.norm2_g + l * DM, l, 4 * DM, scr, r); continue; } r -= I_1;
        if (r < I_O) { p1_transpose_item(F, F.w_out + (size_t)l * DM * DM, DM, DM, F.wout_t + (size_t)l * DM * DM, 0, 1, nullptr, l, 0, scr, r); continue; } r -= I_O;
        p1_transpose_item(F, F.w_mlp2 + (size_t)l * DFF * DM, DFF, DM, F.w2_t + (size_t)l * DM * DFF, 0, 1, nullptr, l, 0, scr, r);
    }
}

typedef short cg_bf16x8 __attribute__((ext_vector_type(8)));
template <int MODE> __device__ __forceinline__ void ctx_gemm(Frame& F, const bf16* A, const bf16* Bt, int K, int ct0, int nct,
                                                            bf16* O, int ldo, const float* stat_in, const float* vecp  ,
                                                            const float* xi, float* xo, float* stat_out, const float* hnq = nullptr, const float* hnk = nullptr) {
    const int lane = F.lane, wave = F.wave, tid = F.tid, fr = lane & 15, fq = lane >> 4;
    LAS float* red = (LAS float*)(F.lds + RING_OFF);
    const int kslice = K / NWAVES;
    for (int it = blockIdx.x; it < 8 * nct; it += F.G) {
        const int rt = it & 7, ct = ct0 + (it >> 3), r0 = rt * 64, n0 = ct * 64;
        f32x4 acc[4][4];
#pragma unroll
        for (int mi = 0; mi < 4; ++mi)
#pragma unroll
            for (int ni = 0; ni < 4; ++ni) acc[mi][ni] = (f32x4){0.f, 0.f, 0.f, 0.f};
        const bf16* ap = A + (size_t)(r0 + fr) * K + wave * kslice + 8 * fq;
        const bf16* bp = Bt + (size_t)(n0 + fr) * K + wave * kslice + 8 * fq;
#pragma unroll 1
        for (int kc = 0; kc < kslice; kc += 128) {
            cg_bf16x8 af[4][4], bf[4][4];
#pragma unroll
            for (int kk = 0; kk < 4; ++kk)
#pragma unroll
                for (int i = 0; i < 4; ++i) { af[kk][i] = *(const cg_bf16x8*)(ap + (size_t)(16 * i) * K + kc + 32 * kk); bf[kk][i] = *(const cg_bf16x8*)(bp + (size_t)(16 * i) * K + kc + 32 * kk); }
#pragma unroll
            for (int kk = 0; kk < 4; ++kk)
#pragma unroll
                for (int mi = 0; mi < 4; ++mi)
#pragma unroll
                    for (int ni = 0; ni < 4; ++ni) acc[mi][ni] = __builtin_amdgcn_mfma_f32_16x16x32_bf16(bf[kk][ni], af[kk][mi], acc[mi][ni], 0, 0, 0);
        }
        __syncthreads();
#pragma unroll
        for (int mi = 0; mi < 4; ++mi)
#pragma unroll
            for (int ni = 0; ni < 4; ++ni) *(LAS f32x4*)(red + wave * 4096 + (16 * mi + fr) * 64 + 16 * ni + 4 * fq) = acc[mi][ni];
        __syncthreads();
        const int rl = tid >> 3, c8 = (tid & 7) * 8, row = r0 + rl, col = n0 + c8;
        f32x4 v0 = (f32x4){0.f, 0.f, 0.f, 0.f}, v1 = v0;
#pragma unroll
        for (int w = 0; w < NWAVES; ++w) { v0 += *(const LAS f32x4*)(red + w * 4096 + rl * 64 + c8); v1 += *(const LAS f32x4*)(red + w * 4096 + rl * 64 + c8 + 4); }
        if (MODE == 0 || MODE == 2) {
            float ss = 0.f;
#pragma unroll
            for (int j = 0; j < 4; ++j) { const f32x4 p = *(const f32x4*)(stat_in + (size_t)row * 16 + 4 * j); ss += (p[0] + p[1]) + (p[2] + p[3]); }
            const float rs = 1.0f / sqrtf(ss * (1.0f / 1024.0f) + EPS);
            const f32x4 b0 = *(const f32x4*)(vecp + col), b1 = *(const f32x4*)(vecp + col + 4);
            v0 = v0 * rs + b0; v1 = v1 * rs + b1;
            if (MODE == 0 && hnq != nullptr && ct >= OFF_Q / 64 && ct < OFF_V / 64) {
                float ss = (v0[0] * v0[0] + v0[1] * v0[1]) + (v0[2] * v0[2] + v0[3] * v0[3]) + (v1[0] * v1[0] + v1[1] * v1[1]) + (v1[2] * v1[2] + v1[3] * v1[3]);
                ss = xadd<1>(ss); ss = xadd<2>(ss); ss = xadd<4>(ss);
                const float rn = 1.0f / sqrtf(ss * (1.0f / 64.0f) + EPS);
                const bool isq = ct < OFF_K / 64; const float* gp = (isq ? hnq : hnk) + c8; const float gm = isq ? QSCALE * rn : rn;
                const f32x4 g0 = *(const f32x4*)gp, g1 = *(const f32x4*)(gp + 4);
                v0 = v0 * g0 * gm; v1 = v1 * g1 * gm;
            }
            if (MODE == 2) {
#pragma unroll
                for (int e = 0; e < 4; ++e) { const float a = fmaxf(v0[e], 0.f), b = fmaxf(v1[e], 0.f); v0[e] = a * a; v1[e] = b * b; } }
            v4u w; w.x = pk2(v0[0], v0[1]); w.y = pk2(v0[2], v0[3]); w.z = pk2(v1[0], v1[1]); w.w = pk2(v1[2], v1[3]);
            if (MODE == 0) *(v4u*)(O + u_idx(MLAT + row, col)) = w;
            else *(v4u*)(O + (size_t)(MLAT + row) * ldo + col) = w;
        } else {
            const f32x4 g0 = *(const f32x4*)(vecp + col), g1 = *(const f32x4*)(vecp + col + 4);
            const f32x4 a0 = *(const f32x4*)(xi + (size_t)row * DM + col), a1 = *(const f32x4*)(xi + (size_t)row * DM + col + 4);
            const f32x4 o0 = a0 + g0 * v0, o1 = a1 + g1 * v1;
            *(f32x4*)(xo + (size_t)row * DM + col) = o0; *(f32x4*)(xo + (size_t)row * DM + col + 4) = o1;
            v4u w; w.x = pk2(o0[0], o0[1]); w.y = pk2(o0[2], o0[3]); w.z = pk2(o1[0], o1[1]); w.w = pk2(o1[2], o1[3]);
            *(v4u*)(O + (size_t)(MLAT + row) * ldo + col) = w;
            float ss = (o0[0] * o0[0] + o0[1] * o0[1]) + (o0[2] * o0[2] + o0[3] * o0[3]) + (o1[0] * o1[0] + o1[1] * o1[1]) + (o1[2] * o1[2] + o1[3] * o1[3]);
            ss = xadd<1>(ss); ss = xadd<2>(ss); ss = xadd<4>(ss);
            if ((tid & 7) == 0) stat_out[(size_t)row * 16 + ct] = ss;
        }
    }
    __syncthreads();
}

constexpr int CV_OB = 65536 + 1024;
constexpr int CV_ST = CV_OB + 64 * 256 * 2;
static_assert(94 * 256 * 4 <= RING_BYTES && CV_ST + 512 <= RING_BYTES, "conv LDS map");
__device__ __forceinline__ void unpack8(const v4u w, float (&f)[8]) { f[0] = bflo(w.x); f[1] = bfhi(w.x); f[2] = bflo(w.y); f[3] = bfhi(w.y); f[4] = bflo(w.z); f[5] = bfhi(w.z); f[6] = bflo(w.w); f[7] = bfhi(w.w); }
__device__ __forceinline__ void conv_tile(Frame& F, int layer, int ti) {
    const int tid = F.tid, r0 = ti * 64;
    int s0, s1;
    if (r0 < MLAT) { s0 = r0 & ~(SEQ - 1); s1 = s0 + SEQ; } else { s0 = MLAT + ((r0 - MLAT) & ~(CTXL - 1)); s1 = s0 + CTXL; }
    LAS float* zl = (LAS float*)(F.lds + RING_OFF);
    LAS bf16* ob = (LAS bf16*)(F.lds + RING_OFF + CV_OB);
    LAS float* st = (LAS float*)(F.lds + RING_OFF + CV_ST);
    int cg_ = tid & 31; asm volatile("" : "+v"(cg_)); const int cg = cg_;
    const char* ub = (const char*)F.u; constexpr unsigned UPB = (unsigned)(UPS * 2);
    v4u zv[6], zg[6]; bool zok[6];
#pragma unroll
    for (int i = 0; i < 6; ++i) { const int rr = (tid >> 5) + 16 * i, row = r0 - 15 + rr; zok[i] = (rr < 94) && (row >= s0) && (row < s1);
        const unsigned off = (unsigned)(OFF_C / 256) * UPB + (unsigned)(zok[i] ? row : r0) * 512u + (unsigned)(16 * cg); zv[i] = *(const v4u*)(ub + off); zg[i] = *(const v4u*)(ub + off + UPB); }
    const int rb = r0 + 4 * (tid >> 5);
    v4u ax[6], ac[6]; bool aok[6];
#pragma unroll
    for (int k = 0; k < 6; ++k) { const int row = rb - 1 + k; aok[k] = (row >= s0) && (row < s1);
        const unsigned off = (unsigned)(aok[k] ? row : r0) * 512u + (unsigned)(16 * cg); ax[k] = *(const v4u*)(ub + off); ac[k] = *(const v4u*)(ub + off + 2u * UPB); }
    __syncthreads();
#pragma unroll
    for (int i = 0; i < 6; ++i) { const int rr = (tid >> 5) + 16 * i; float a[8], g[8]; unpack8(zv[i], a); unpack8(zg[i], g);
        f32x4 z0, z1;
#pragma unroll
        for (int e = 0; e < 4; ++e) { z0[e] = zok[i] ? a[e] * sigmoidf_(g[e]) : 0.f; z1[e] = zok[i] ? a[4 + e] * sigmoidf_(g[4 + e]) : 0.f; }
        if (rr < 94) { *(LAS f32x4*)(zl + rr * 256 + 8 * cg) = z0; *(LAS f32x4*)(zl + rr * 256 + 8 * cg + 4) = z1; } }
    {
        v4u ab[4];
#pragma unroll
        for (int k = 0; k < 4; ++k) ab[k] = *(const v4u*)(ub + UPB + (unsigned)(rb + k) * 512u + (unsigned)(16 * cg));
        const float* wa = F.conv_a_w + (size_t)layer * 3 * 256 + 8 * cg;
        float w0[8], w1[8], w2[8];
#pragma unroll
        for (int e = 0; e < 8; ++e) { w0[e] = wa[e]; w1[e] = wa[256 + e]; w2[e] = wa[512 + e]; }
        float pm[8], pc[8], pn[8];
        { float x[8], c[8]; unpack8(ax[0], x); unpack8(ac[0], c);
#pragma unroll
          for (int e = 0; e < 8; ++e) pm[e] = aok[0] ? x[e] * c[e] : 0.f;
          unpack8(ax[1], x); unpack8(ac[1], c);
#pragma unroll
          for (int e = 0; e < 8; ++e) pc[e] = aok[1] ? x[e] * c[e] : 0.f; }
#pragma unroll
        for (int k = 0; k < 4; ++k) { float x[8], c[8], b[8]; unpack8(ax[k + 2], x); unpack8(ac[k + 2], c); unpack8(ab[k], b);
#pragma unroll
            for (int e = 0; e < 8; ++e) pn[e] = aok[k + 2] ? x[e] * c[e] : 0.f;
            float y[8];
#pragma unroll
            for (int e = 0; e < 8; ++e) y[e] = b[e] * (w0[e] * pm[e] + w1[e] * pc[e] + w2[e] * pn[e]);
            v4u o; o.x = pk2(y[0], y[1]); o.y = pk2(y[2], y[3]); o.z = pk2(y[4], y[5]); o.w = pk2(y[6], y[7]);
            *(v4u*)(F.y + (size_t)(rb + k) * DM + 8 * cg) = o;
#pragma unroll
            for (int e = 0; e < 8; ++e) { pm[e] = pc[e]; pc[e] = pn[e]; } }
    }
    __syncthreads();
    int c_ = tid & 255; asm volatile("" : "+v"(c_));
    const int c = c_, half = tid >> 8;
    float acc[32];
    {
        float w[31];
#pragma unroll
        for (int j = 0; j < 31; ++j) w[j] = F.conv_c_w[(size_t)layer * 31 * 256 + j * 256 + c];
        const float bias = F.conv_c_b[layer * 256 + c];
#pragma unroll
        for (int i = 0; i < 32; ++i) acc[i] = bias;
#pragma unroll
        for (int r = 0; r < 62; ++r) { const float zv1 = zl[(half * 32 + r) * 256 + c];
#pragma unroll
            for (int i = 0; i < 32; ++i) { const int j = r - i; if (j >= 0 && j <= 30) acc[i] += w[j] * zv1; } }
    }
    __syncthreads();
#pragma unroll
    for (int i = 0; i < 32; ++i) zl[(half * 32 + i) * 256 + c] = acc[i];
    __syncthreads();
    {
        const int t = tid >> 3, part = tid & 7, lane = tid & 63; float sm = 0.f;
#pragma unroll 8
        for (int i = 0; i < 32; ++i) sm += zl[t * 256 + part * 32 + ((i + lane) & 31)];
        sm = xadd<1>(sm); sm = xadd<2>(sm); sm = xadd<4>(sm);
        const float mean = sm * (1.0f / 256.0f); float q = 0.f;
#pragma unroll 8
        for (int i = 0; i < 32; ++i) { const float d = zl[t * 256 + part * 32 + ((i + lane) & 31)] - mean; q += d * d; }
        q = xadd<1>(q); q = xadd<2>(q); q = xadd<4>(q);
        if (part == 0) { st[t * 2] = mean; st[t * 2 + 1] = 1.0f / sqrtf(q * (1.0f / 256.0f) + EPS); }
    }
    __syncthreads();
    {
        const float g = F.ln_c_g[layer * 256 + c], be = F.ln_c_b[layer * 256 + c];
#pragma unroll
        for (int i = 0; i < 32; ++i) { const int t = half * 32 + i; const float v = (acc[i] - st[t * 2]) * st[t * 2 + 1] * g + be;
            ob[t * 256 + c] = (bf16)f2bf(v * sigmoidf_(v)); }
    }
    __syncthreads();
#pragma unroll
    for (int i = 0; i < 4; ++i) { const int row = (tid >> 5) + 16 * i; const v4u v = *(const LAS v4u*)(ob + row * 256 + 8 * cg); *(v4u*)(F.y + (size_t)(r0 + row) * DM + 768 + 8 * cg) = v; }
}

typedef float f32x16 __attribute__((ext_vector_type(16)));
typedef short bf16x8_t __attribute__((ext_vector_type(8)));
typedef short s16x4_t __attribute__((ext_vector_type(4)));
constexpr int KSTR = 144, VSTR = 192;
constexpr int ATT_VA = 384 * KSTR, ATT_VB = 256 * KSTR;
constexpr int ATT_OST = 256 * KSTR + 256 * VSTR;
constexpr int ATT_LW = ATT_OST + 8 * 4096;
static_assert(ATT_VA + 384 * VSTR <= RING_BYTES && ATT_LW + 8 * 256 <= RING_BYTES, "attention LDS map");
__device__ __forceinline__ int crow(int r, int hi) { return (r & 3) + 8 * (r >> 2) + 4 * hi; }
__device__ __forceinline__ unsigned cvtpk_s(float lo, float hi) { f32x2_t v = {lo, hi}; bf16x2_t b = __builtin_convertvector(v, bf16x2_t); return __builtin_bit_cast(unsigned, b); }
__device__ __forceinline__ s16x4_t vtr(const LAS unsigned char* p) { return __builtin_bit_cast(s16x4_t, __builtin_amdgcn_ds_read_tr16_b64_v4i16((LAS s16x4_t*)p)); }

__device__ __forceinline__ void attn_stage(Frame& F, int row0, int nkeys, int kvh, int voff) {
    for (int idx = F.tid; idx < nkeys * 8; idx += NWAVES * 64) { const int key = idx >> 3, c = idx & 7;
        const bf16* src = F.u + u_idx(row0 + key, OFF_K + kvh * HD + 8 * c);
        const v4u kv = *(const v4u*)(src), vv = *(const v4u*)(src + (OFF_V - OFF_K));
        *(LAS v4u*)(F.lds + key * KSTR + 16 * c) = kv; *(LAS v4u*)(F.lds + voff + key * VSTR + 16 * c) = vv; }
}
template <int MASK> __device__ __forceinline__ void attn_half_tile(bf16x8_t (&ka)[4], const LAS unsigned char* kpn_, const LAS unsigned char* vp_, const bf16x8_t (&qf)[2][4], f32x16 (&o)[2][2], float (&lsum)[2], float negshift, int hh, int kb, int qi0) {
    unsigned kpi = (unsigned)(size_t)kpn_, vpi = (unsigned)(size_t)vp_; asm volatile("" : "+v"(kpi), "+v"(vpi));
    const LAS unsigned char* kpn = (const LAS unsigned char*)(size_t)kpi; const LAS unsigned char* vp = (const LAS unsigned char*)(size_t)vpi;
    f32x16 p0, p1;
#pragma unroll
    for (int r = 0; r < 16; ++r) { p0[r] = negshift; p1[r] = negshift; }
#pragma unroll
    for (int ds = 0; ds < 4; ++ds) { p0 = __builtin_amdgcn_mfma_f32_32x32x16_bf16(ka[ds], qf[0][ds], p0, 0, 0, 0); p1 = __builtin_amdgcn_mfma_f32_32x32x16_bf16(ka[ds], qf[1][ds], p1, 0, 0, 0); }
    __builtin_amdgcn_sched_barrier(0);
#pragma unroll
    for (int ds = 0; ds < 4; ++ds) ka[ds] = *(const LAS bf16x8_t*)(kpn + ds * 32);
    s16x4_t vlo[2], vhi[2];
#pragma unroll
    for (int db = 0; db < 2; ++db) { vlo[db] = vtr(vp + db * 64); vhi[db] = vtr(vp + 8 * VSTR + db * 64); }
    __builtin_amdgcn_sched_barrier(0);
    float s0 = 0.f, s1 = 0.f;
#pragma unroll
    for (int r = 0; r < 16; ++r) {
        float e0 = __builtin_amdgcn_exp2f(p0[r]), e1 = __builtin_amdgcn_exp2f(p1[r]);
        if (MASK == 1) { const int kidx = kb + crow(r, hh); e0 = (kidx >= qi0) ? e0 : 0.f; e1 = (kidx >= qi0 + 32) ? e1 : 0.f; }
        if (MASK == 2) { const int kidx = kb + crow(r, hh); e0 = (kidx <= qi0) ? e0 : 0.f; e1 = (kidx <= qi0 + 32) ? e1 : 0.f; }
        p0[r] = e0; p1[r] = e1; s0 += e0; s1 += e1; }
    lsum[0] += s0; lsum[1] += s1;
#pragma unroll
    for (int ks = 0; ks < 2; ++ks) {
        v4u w0, w1;
        w0.x = cvtpk_s(p0[8 * ks + 0], p0[8 * ks + 1]); w0.y = cvtpk_s(p0[8 * ks + 2], p0[8 * ks + 3]); w0.z = cvtpk_s(p0[8 * ks + 4], p0[8 * ks + 5]); w0.w = cvtpk_s(p0[8 * ks + 6], p0[8 * ks + 7]);
        w1.x = cvtpk_s(p1[8 * ks + 0], p1[8 * ks + 1]); w1.y = cvtpk_s(p1[8 * ks + 2], p1[8 * ks + 3]); w1.z = cvtpk_s(p1[8 * ks + 4], p1[8 * ks + 5]); w1.w = cvtpk_s(p1[8 * ks + 6], p1[8 * ks + 7]);
        const bf16x8_t pa0 = __builtin_bit_cast(bf16x8_t, w0), pa1 = __builtin_bit_cast(bf16x8_t, w1);
        bf16x8_t vf[2];
#pragma unroll
        for (int db = 0; db < 2; ++db) vf[db] = (bf16x8_t){vlo[db][0], vlo[db][1], vlo[db][2], vlo[db][3], vhi[db][0], vhi[db][1], vhi[db][2], vhi[db][3]};
        if (ks == 0) {
#pragma unroll
            for (int db = 0; db < 2; ++db) { vlo[db] = vtr(vp + 16 * VSTR + db * 64); vhi[db] = vtr(vp + 24 * VSTR + db * 64); }
            __builtin_amdgcn_sched_barrier(0);
        }
#pragma unroll
        for (int db = 0; db < 2; ++db) {
            o[0][db] = __builtin_amdgcn_mfma_f32_32x32x16_bf16(pa0, vf[db], o[0][db], 0, 0, 0);
            o[1][db] = __builtin_amdgcn_mfma_f32_32x32x16_bf16(pa1, vf[db], o[1][db], 0, 0, 0); }
    }
}
__device__ __forceinline__ void attn_unit(Frame& F, int layer, int item) {
    const int lane = F.lane, wave = F.wave, r32 = lane & 31, hh = lane >> 5;
    const bool lat = item < NBATCH * NKV * (SEQ / 128);
    int b, kvh, qb, qrow0;
    if (lat) { b = item / (NKV * (SEQ / 128)); const int r = item % (NKV * (SEQ / 128)); kvh = r / (SEQ / 128); qb = r % (SEQ / 128); qrow0 = b * SEQ + qb * 128; }
    else { const int it = item - NBATCH * NKV * (SEQ / 128); b = it >> 2; kvh = (it >> 1) & 1; qb = it & 1; qrow0 = MLAT + b * CTXL + qb * 128; }
    const int crow0 = MLAT + b * CTXL;
    const int h = kvh * 4 + (wave >> 1), th = wave & 1;
    float mq = fabsf(F.q_norm_g[layer * HD + lane]), mk = fabsf(F.k_norm_g[layer * HD + lane]);
    mq = xmaxk<1>(mq); mq = xmaxk<2>(mq); mq = xmaxk<4>(mq); mq = xmaxk<8>(mq); mq = xmaxk<16>(mq); mq = xmaxk<32>(mq);
    mk = xmaxk<1>(mk); mk = xmaxk<2>(mk); mk = xmaxk<4>(mk); mk = xmaxk<8>(mk); mk = xmaxk<16>(mk); mk = xmaxk<32>(mk);
    const float shift = 8.0f * 1.03f * 1.4426950408889634f * mq * mk, negshift = -shift;
    bf16x8_t qf[2][4];
#pragma unroll
    for (int s = 0; s < 2; ++s) { const bf16* qp = F.u + u_idx(qrow0 + 64 * th + 32 * s + r32, OFF_Q + h * HD + 8 * hh);
#pragma unroll
        for (int ds = 0; ds < 4; ++ds) qf[s][ds] = *(const bf16x8_t*)(qp + 16 * ds); }
    f32x16 o[2][2];
#pragma unroll
    for (int s = 0; s < 2; ++s)
#pragma unroll
        for (int db = 0; db < 2; ++db)
#pragma unroll
            for (int r = 0; r < 16; ++r) o[s][db][r] = 0.f;
    float lsum[2] = {0.f, 0.f};
    const int qi0 = 64 * th + r32;
    const int kfo = r32 * KSTR + hh * 16;
    const int vfo = (4 * hh + ((lane & 15) >> 2)) * VSTR + (16 * ((lane >> 4) & 1) + 4 * (lane & 3)) * 2;
    const LAS unsigned char* L = F.lds;
    bf16x8_t ka[4];
    if (lat) {
        const int s_lo = (qb == 0) ? 128 : 0, s_hi = (qb == SEQ / 128 - 1) ? 256 : 384;
        {
            const int row_s0 = b * SEQ + 128 * (qb - 1);
            v4u kr[6], vr[6];
#pragma unroll
            for (int i = 0; i < 6; ++i) { const int idx = F.tid + 512 * i, key = idx >> 3, c = idx & 7; const int keyc = (key >= s_lo && key < s_hi) ? key : 128;
                const bf16* src = F.u + u_idx(row_s0 + keyc, OFF_K + kvh * HD + 8 * c); kr[i] = *(const v4u*)(src); vr[i] = *(const v4u*)(src + (OFF_V - OFF_K)); }
            __syncthreads();
#pragma unroll
            for (int i = 0; i < 6; ++i) { const int idx = F.tid + 512 * i, key = idx >> 3, c = idx & 7;
                *(LAS v4u*)(F.lds + key * KSTR + 16 * c) = kr[i]; *(LAS v4u*)(F.lds + ATT_VA + key * VSTR + 16 * c) = vr[i]; }
        }
        __syncthreads();
        {
            const LAS unsigned char* k0 = L + ((qb > 0) ? 64 * th : 128) * KSTR + kfo;
#pragma unroll
            for (int ds = 0; ds < 4; ++ds) ka[ds] = *(const LAS bf16x8_t*)(k0 + ds * 32);
        }
        if (qb > 0) {
#pragma unroll 1
            for (int hk = 2 * th; hk < 4; ++hk) attn_half_tile<1>(ka, L + (32 * hk + 32) * KSTR + kfo, L + ATT_VA + (32 * hk) * VSTR + vfo, qf, o, lsum, negshift, hh, 32 * hk, qi0);
        }
#pragma unroll 1
        for (int hk = 0; hk < 4; ++hk) attn_half_tile<0>(ka, L + (128 + 32 * hk + 32) * KSTR + kfo, L + ATT_VA + (128 + 32 * hk) * VSTR + vfo, qf, o, lsum, negshift, hh, 0, 0);
        if (qb < SEQ / 128 - 1) {
#pragma unroll 1
            for (int hk = 0; hk < 2 * th + 2; ++hk) attn_half_tile<2>(ka, L + (256 + 32 * hk + 32) * KSTR + kfo, L + ATT_VA + (256 + 32 * hk) * VSTR + vfo, qf, o, lsum, negshift, hh, 32 * hk, qi0);
        }
    }
    {
        v4u kr[4], vr[4];
#pragma unroll
        for (int i = 0; i < 4; ++i) { const int idx = F.tid + 512 * i, key = idx >> 3, c = idx & 7;
            const bf16* src = F.u + u_idx(crow0 + key, OFF_K + kvh * HD + 8 * c); kr[i] = *(const v4u*)(src); vr[i] = *(const v4u*)(src + (OFF_V - OFF_K)); }
        __syncthreads();
#pragma unroll
        for (int i = 0; i < 4; ++i) { const int idx = F.tid + 512 * i, key = idx >> 3, c = idx & 7;
            *(LAS v4u*)(F.lds + key * KSTR + 16 * c) = kr[i]; *(LAS v4u*)(F.lds + ATT_VB + key * VSTR + 16 * c) = vr[i]; }
    }
    __syncthreads();
#pragma unroll
    for (int ds = 0; ds < 4; ++ds) ka[ds] = *(const LAS bf16x8_t*)(L + kfo + ds * 32);
#pragma unroll 1
    for (int hk = 0; hk < 8; ++hk) attn_half_tile<0>(ka, L + (32 * hk + 32) * KSTR + kfo, L + ATT_VB + (32 * hk) * VSTR + vfo, qf, o, lsum, negshift, hh, 0, 0);
    const float sinkt = __builtin_amdgcn_exp2f(F.attn_sink[layer * NHEAD + h] * 1.4426950408889634f - shift);
    LAS float* lw = (LAS float*)(F.lds + ATT_LW + wave * 256);
    LAS bf16* stg = (LAS bf16*)(F.lds + ATT_OST + wave * 4096);
#pragma unroll
    for (int s = 0; s < 2; ++s) { const float lt = xadd32(lsum[s]) + sinkt; if (hh == 0) lw[s * 32 + r32] = 1.0f / lt; }
    LDS_WAIT(); asm volatile("" ::: "memory");
    int sb_w = ATT_OST + wave * 4096 + (4 * hh * 64 + r32) * 2, lb_r = ATT_LW + wave * 256 + 4 * hh * 4, sb_r = ATT_OST + wave * 4096 + ((lane >> 3) * 64 + (lane & 7) * 8) * 2;
    asm volatile("" : "+v"(sb_w), "+v"(lb_r), "+v"(sb_r));
#pragma unroll
    for (int s = 0; s < 2; ++s) {
#pragma unroll
        for (int r = 0; r < 16; ++r) { const int ro = (r & 3) + 8 * (r >> 2); const float inv = *(const LAS float*)(F.lds + lb_r + (s * 32 + ro) * 4);
#pragma unroll
            for (int db = 0; db < 2; ++db) *(LAS bf16*)(F.lds + sb_w + (ro * 64 + db * 32) * 2) = (bf16)f2bf(o[s][db][r] * inv); }
        LDS_WAIT(); asm volatile("" ::: "memory");
        bf16* yp = F.y + (size_t)(qrow0 + 64 * th + 32 * s + (lane >> 3)) * DM + 256 + h * HD + (lane & 7) * 8;
#pragma unroll
        for (int i = 0; i < 4; ++i) { const v4u v = *(const LAS v4u*)(F.lds + sb_r + i * 8 * 64 * 2); *(v4u*)(yp + (size_t)(i * 8) * DM) = v; }
        LDS_WAIT(); asm volatile("" ::: "memory");
    }
}
__device__ __forceinline__ void mixer_attn_phase(Frame& F, int layer) {
    const bool last = layer == NLAYER - 1;
    const int nunits = NBATCH * NKV * (SEQ / 128) + (last ? 0 : NBATCH * NKV * 2);
    for (int rep = 0; rep < REP_ATT; ++rep)
    for (int it = blockIdx.x; it < nunits; it += F.G) attn_unit(F, layer, it);
}
__device__ __forceinline__ void mixer_conv_phase(Frame& F, int layer) {
    const bool last = layer == NLAYER - 1;
    const int ntiles = (last ? MLAT : MTOT) / 64;
    const int nlat = MLAT / 64, nlr = (nlat - (int)blockIdx.x + F.G - 1) / F.G;
    for (int rep = 0; rep < REP_CONV; ++rep)
    for (int i = 0; ; ++i) { const int ti = (i < nlr) ? (int)blockIdx.x + i * F.G : nlat + (F.G - 1 - (int)blockIdx.x) + (i - nlr) * F.G; if (ti >= ntiles) break; conv_tile(F, layer, ti); }
}

constexpr int N_PHASES = 2 + 5 * NLAYER;
typedef const __attribute__((address_space(4))) Args* KArgs;
__device__ __forceinline__ void make_frame(Frame& F, KArgs a, LAS unsigned char* lds) {
    asm volatile("" : "+s"(a));
    F.lds = lds;
    { int t_ = threadIdx.x; asm volatile("" : "+v"(t_)); F.tid = t_; } F.lane = F.tid & 63; F.wave = __builtin_amdgcn_readfirstlane(F.tid >> 6);
    F.G = gridDim.x; { const int bx = blockIdx.x; F.vcu = (F.G % 8 == 0) ? (bx % 8) * (F.G / 8) + bx / 8 : bx; }
    F.x = a->in[0]; F.c = a->in[1]; F.ctx = a->in[2]; F.c_ctx = a->in[3]; F.w_mod = a->in[4]; F.b_mod = a->in[5]; F.norm1_g = a->in[6]; F.w_in = a->in[7];
    F.conv_a_w = a->in[8]; F.q_norm_g = a->in[9]; F.k_norm_g = a->in[10]; F.attn_sink = a->in[11]; F.conv_c_w = a->in[12]; F.conv_c_b = a->in[13]; F.ln_c_g = a->in[14]; F.ln_c_b = a->in[15];
    F.w_out = a->in[16]; F.norm2_g = a->in[17]; F.w_mlp1 = a->in[18]; F.w_mlp2 = a->in[19];
    F.out = a->out;
    unsigned char* ws = a->ws;
    F.modp = (float*)(ws + WS_MODP); F.mod = (float*)(ws + WS_MOD); F.bias1 = (float*)(ws + WS_BIAS1); F.bias2 = (float*)(ws + WS_BIAS2); F.rope = (float*)(ws + WS_ROPE);
    F.stat1 = (float*)(ws + WS_STAT1); F.stat2 = (float*)(ws + WS_STAT2); F.statc1 = (float*)(ws + WS_STATC1); F.statc2 = (float*)(ws + WS_STATC2); F.xc = (float*)(ws + WS_XC);
    F.win_t = (bf16*)(ws + WS_WIN); F.wout_t = (bf16*)(ws + WS_WOUT); F.w1_t = (bf16*)(ws + WS_W1); F.w2_t = (bf16*)(ws + WS_W2);
    F.xb = (bf16*)(ws + WS_XB); F.u = (bf16*)(ws + WS_U); F.y = (bf16*)(ws + WS_Y); F.h = (bf16*)(ws + WS_H);
}
__global__ void __launch_bounds__(NWAVES * 64, 2) mk_fwd(Args args_unused) {
    extern __shared__ __attribute__((aligned(16))) unsigned char lds[];
    LAS unsigned char* const ldsp = (LAS unsigned char*)lds;
    const KArgs ka = (KArgs)__builtin_amdgcn_kernarg_segment_ptr();
    const int tid0 = threadIdx.x;
    for (int u = tid0; u < (LDS_BYTES - LDSCTL_OFF) / 4; u += NWAVES * 64) ((LAS unsigned*)(ldsp + LDSCTL_OFF))[u] = 0u;
    __syncthreads();
    const int lo = ka->ph_lo, hi = ka->ph_hi;
#if MK_PER_PHASE
#define GRID_BAR() do { } while (0)
#else
    XcdBarrier bar = xcd_barrier_post((unsigned*)((gu32*)(ka->ws + WS_CTL) + CW_BAR), (volatile LAS unsigned*)(ldsp + MISC_OFF) + 8);
#define GRID_BAR() xcd_barrier(bar)
#endif
#define IN(k) (lo <= (k) && (k) < hi)
#define SEAM(k) do { if (IN(k) && IN((k) + 1)) GRID_BAR(); } while (0)

    for (int rep01 = 0; rep01 < REP_P01; ++rep01) {
#ifndef SKP0
    if (IN(0)) { Frame F; make_frame(F, ka, ldsp); p0_phase(F); }
#endif
    SEAM(0);
#ifndef SKP1
    if (IN(1)) { Frame F; make_frame(F, ka, ldsp); p1_phase(F); }
#endif
    SEAM(1);
    }
#pragma unroll 1
    for (int layer = 0; layer < NLAYER; ++layer) {
        const int pb = 2 + 5 * layer; const bool last = layer == NLAYER - 1;
#ifndef SKG0
        if (IN(pb + 0)) for (int rep = 0; rep < REP_G0; ++rep) {
            Frame F; make_frame(F, ka, ldsp);
            const bf16* wv2 = F.win_t + (size_t)layer * 3 * DIN * DM + (size_t)2 * DIN * DM;
#if defined(PROBE_LDC)
            if (layer == 0) { pg8::Gemm g{F.h, F.win_t + (size_t)layer * 3 * DIN * DM, MLAT, DIN, DM, (size_t)DIN * DM * 2, PROBE_LDA}; pg8::StaticOrder S; S.init(MLAT, DIN, F.G, (int)blockIdx.x); pg8::EpiNormAct<0> Ed{F.h, PROBE_LDC, F.stat1, F.bias1 + (size_t)layer * 3 * DIN, DIN, DIN, pg8::EpiTabs{(LAS int*)(ldsp + EPI_US_OFF), (LAS float*)(ldsp + EPI_RS_OFF), (LAS float*)(ldsp + EPI_BT_OFF), (LAS float*)(ldsp + EPI_S_OFF), (LAS float*)(ldsp + EPI_B1_OFF)}, EPS};
                pg8::gemm_phase<pg8::EpiNormAct<0>, pg8::StaticOrder, true, true>(ldsp + RING_OFF, g, S, Ed); }
#endif
            ctx_gemm<0>(F, F.xb + (size_t)MLAT * DM, wv2, DM, last ? OFF_K / 64 : 0, last ? (OFF_C - OFF_K) / 64 : DIN / 64, F.u, DIN, F.statc1, F.bias1 + ((size_t)layer * 3 + 2) * DIN, nullptr, nullptr, nullptr, F.q_norm_g + layer * HD, F.k_norm_g + layer * HD);
            pg8::Gemm g{F.xb, F.win_t + (size_t)layer * 3 * DIN * DM, MLAT, DIN, DM, (size_t)DIN * DM * 2};
            pg8::StaticOrder S; S.init(MLAT, DIN, F.G, (int)blockIdx.x);
            pg8::EpiIn E{F.u, F.stat1, F.bias1 + (size_t)layer * 3 * DIN, F.q_norm_g + layer * HD, F.k_norm_g + layer * HD, F.rope, pg8::EpiTabs{(LAS int*)(ldsp + EPI_US_OFF), (LAS float*)(ldsp + EPI_RS_OFF), (LAS float*)(ldsp + EPI_BT_OFF), (LAS float*)(ldsp + EPI_S_OFF), (LAS float*)(ldsp + EPI_B1_OFF)}, (LAS float*)(ldsp + EPI_P_OFF)  , EPS, QSCALE};
            pg8::gemm_phase<pg8::EpiIn, pg8::StaticOrder, true, true>(ldsp + RING_OFF, g, S, E);
        }
#endif
        SEAM(pb + 0);
#ifndef SKMX
        if (IN(pb + 1)) { for (int rep = 0; rep < REP_MIX; ++rep) { Frame F; make_frame(F, ka, ldsp); mixer_attn_phase(F, layer); } { Frame F; make_frame(F, ka, ldsp); mixer_conv_phase(F, layer); } }
#endif
        SEAM(pb + 1);
#ifndef SKG3
        if (IN(pb + 2)) {
            Frame F; make_frame(F, ka, ldsp);
            if (!last) ctx_gemm<1>(F, F.y + (size_t)MLAT * DM, F.wout_t + (size_t)layer * DM * DM, DM, 0, DM / 64, F.xb, DM, nullptr, F.mod + ((size_t)layer * 3 + 2) * MODW + 2 * DM, F.ctx, F.xc, F.statc2);
            pg8::Gemm g{F.y, F.wout_t + (size_t)layer * DM * DM, MLAT, DM, DM, 0};
            pg8::StaticOrder S; S.init(MLAT, DM, F.G, (int)blockIdx.x);
            for (int rep = 1; rep < REP_G2; ++rep) { pg8::EpiRes<false> E{F.xb, (bf16*)(ka->ws + WS_SCRATCH), nullptr, F.mod + (size_t)layer * 3 * MODW + 2 * DM, MODW, (float*)(ka->ws + WS_SCRATCH + 80 * MiB), (LAS float*)(ldsp + EPI_P_OFF)};
                pg8::gemm_phase<pg8::EpiRes<false>, pg8::StaticOrder, true, true>(ldsp + RING_OFF, g, S, E); }
            pg8::EpiRes<false> E{F.xb, F.xb, nullptr, F.mod + (size_t)layer * 3 * MODW + 2 * DM, MODW, F.stat2, (LAS float*)(ldsp + EPI_P_OFF)};
            pg8::gemm_phase<pg8::EpiRes<false>, pg8::StaticOrder, true, true>(ldsp + RING_OFF, g, S, E);
        }
#endif
        SEAM(pb + 2);
#ifndef SKG4
        if (IN(pb + 3)) for (int rep = 0; rep < REP_G4; ++rep) {
            Frame F; make_frame(F, ka, ldsp);
            int par = ((int)blockIdx.x >> 3) & 1; asm volatile("" : "+s"(par));
#pragma unroll 1
            for (int pass = 0; pass < 2; ++pass) {
            if (pass == par) {
            if (!last) ctx_gemm<2>(F, F.xb + (size_t)MLAT * DM, F.w1_t + (size_t)layer * 3 * DFF * DM + (size_t)2 * DFF * DM, DM, 0, DFF / 64, F.h, DFF, F.statc2, F.bias2 + ((size_t)layer * 3 + 2) * DFF, nullptr, nullptr, nullptr);
            } else {
            pg8::Gemm g{F.xb, F.w1_t + (size_t)layer * 3 * DFF * DM, MLAT, DFF, DM, (size_t)DFF * DM * 2};
            pg8::StaticOrder S; S.init(MLAT, DFF, F.G, (int)blockIdx.x);
            pg8::EpiNormAct<1> E{F.h, DM, F.stat2, F.bias2 + (size_t)layer * 3 * DFF, DFF, DFF, pg8::EpiTabs{(LAS int*)(ldsp + EPI_US_OFF), (LAS float*)(ldsp + EPI_RS_OFF), (LAS float*)(ldsp + EPI_BT_OFF), (LAS float*)(ldsp + EPI_S_OFF), (LAS float*)(ldsp + EPI_B1_OFF)}, EPS, (size_t)MLAT * DM};
            pg8::gemm_phase<pg8::EpiNormAct<1>, pg8::StaticOrder, true, true>(ldsp + RING_OFF, g, S, E);
            } }
        }
#endif
        SEAM(pb + 3);
#ifndef SKG5
        if (IN(pb + 4)) {
            Frame F; make_frame(F, ka, ldsp);
            if (!last) ctx_gemm<1>(F, F.h + (size_t)MLAT * DFF, F.w2_t + (size_t)layer * DM * DFF, DFF, 0, DM / 64, F.xb, DM, nullptr, F.mod + ((size_t)layer * 3 + 2) * MODW + 5 * DM, F.xc, F.xc, F.statc1);
            pg8::Gemm g{F.h, F.w2_t + (size_t)layer * DM * DFF, MLAT, DM, DFF, 0, DM, (size_t)MLAT * DM * 2};
            pg8::StaticOrder S; S.init(MLAT, DM, F.G, (int)blockIdx.x);
            for (int rep = 1; rep < REP_G5; ++rep) { pg8::EpiRes<false> E{F.xb, (bf16*)(ka->ws + WS_SCRATCH), nullptr, F.mod + (size_t)layer * 3 * MODW + 5 * DM, MODW, (float*)(ka->ws + WS_SCRATCH + 80 * MiB), (LAS float*)(ldsp + EPI_P_OFF)};
                pg8::gemm_phase<pg8::EpiRes<false>, pg8::StaticOrder, true, true>(ldsp + RING_OFF, g, S, E); }
            if (!last) { pg8::EpiRes<false> E{F.xb, F.xb, nullptr, F.mod + (size_t)layer * 3 * MODW + 5 * DM, MODW, F.stat1, (LAS float*)(ldsp + EPI_P_OFF)};
                pg8::gemm_phase<pg8::EpiRes<false>, pg8::StaticOrder, true, true>(ldsp + RING_OFF, g, S, E); }
            else { pg8::EpiRes<true> E{F.xb, nullptr, F.out, F.mod + (size_t)layer * 3 * MODW + 5 * DM, MODW, nullptr, (LAS float*)(ldsp + EPI_P_OFF)};
                pg8::gemm_phase<pg8::EpiRes<true>, pg8::StaticOrder, true, true>(ldsp + RING_OFF, g, S, E); }
        }
#endif
        if (!last) SEAM(pb + 4);
    }
#undef IN
#undef SEAM
}

extern "C" void kernel_launch(void* const* d_in, const int* in_sizes, int n_in, void* d_out, int out_size, void* d_ws, size_t ws_size, hipStream_t stream) {
    static int grid = 0;
    if (grid == 0) {
        if (n_in != 20 || in_sizes[0] != MLAT * DM || out_size != MLAT * DM || ws_size < WS_END) {
            fprintf(stderr, "kernel_launch: unexpected shapes: n_in %d in0 %d out %d ws %zu (need >= %zu); nothing launched\n", n_in, n_in > 0 ? in_sizes[0] : -1, out_size, ws_size, (size_t)WS_END); grid = -1; return; }
        int dev = 0, cus = 0;
        if (hipGetDevice(&dev) != hipSuccess || hipDeviceGetAttribute(&cus, hipDeviceAttributeMultiprocessorCount, dev) != hipSuccess) { fprintf(stderr, "kernel_launch: device query failed\n"); grid = -1; return; }
        if (hipFuncSetAttribute((const void*)mk_fwd, hipFuncAttributeMaxDynamicSharedMemorySize, LDS_BYTES) != hipSuccess) { fprintf(stderr, "kernel_launch: hipFuncSetAttribute failed\n"); grid = -1; return; }
        int per_cu = 0;
        if (hipOccupancyMaxActiveBlocksPerMultiprocessor(&per_cu, (const void*)mk_fwd, NWAVES * 64, LDS_BYTES) != hipSuccess || per_cu < 1)
            fprintf(stderr, "kernel_launch: note: occupancy query reports %d workgroups per CU\n", per_cu);
        (void)hipGetLastError();
        grid = cus;
    }
    if (grid < 0) return;
    if (hipMemsetAsync((char*)d_ws + WS_CTL, 0, CTL_ZERO_BYTES, stream) != hipSuccess) { fprintf(stderr, "kernel_launch: memset failed\n"); return; }
    Args a{};
    for (int i = 0; i < 20; ++i) a.in[i] = (const float*)d_in[i];
    a.out = (float*)d_out; a.ws = (unsigned char*)d_ws;
#if MK_PER_PHASE
    for (int ph = 0; ph < N_PHASES; ++ph) {
        a.ph_lo = ph; a.ph_hi = ph + 1;
        hipLaunchKernelGGL(mk_fwd, dim3(grid), dim3(NWAVES * 64), LDS_BYTES, stream, a);
    }
#else
    a.ph_lo = 0; a.ph_hi = N_PHASES;
    hipLaunchKernelGGL(mk_fwd, dim3(grid), dim3(NWAVES * 64), LDS_BYTES, stream, a);
#endif
    const hipError_t le = hipPeekAtLastError();
    if (le != hipSuccess) fprintf(stderr, "kernel_launch: launch failed: %s\n", hipGetErrorName(le));
}
```

```cpp
#include <hip/hip_runtime.h>
#include <cstdio>
#include <cstdint>

template <int K> __device__ __forceinline__ float xlane_f(float v) {
    return __builtin_bit_cast(float, __builtin_amdgcn_ds_swizzle(__builtin_bit_cast(int, v), (K << 10) | 0x1F));
}
__device__ __forceinline__ float xadd32(float v) { const unsigned b = __float_as_uint(v); auto r = __builtin_amdgcn_permlane32_swap(b, b, false, false); const unsigned r0 = r[0], r1 = r[1]; return __uint_as_float(r0) + __uint_as_float(r1); }
__device__ __forceinline__ float xmax32(float v) { const unsigned b = __float_as_uint(v); auto r = __builtin_amdgcn_permlane32_swap(b, b, false, false); const unsigned r0 = r[0], r1 = r[1]; return fmaxf(__uint_as_float(r0), __uint_as_float(r1)); }
__device__ __forceinline__ float xget32(float v, bool upper) { const unsigned b = __float_as_uint(v); auto r = __builtin_amdgcn_permlane32_swap(b, b, false, false); const unsigned r0 = r[0], r1 = r[1]; return __uint_as_float(upper ? r0 : r1); }
template <int K> __device__ __forceinline__ float xadd(float v) { if constexpr (K == 32) return xadd32(v); else return v + xlane_f<K>(v); }
template <int K> __device__ __forceinline__ float xmaxk(float v) { if constexpr (K == 32) return xmax32(v); else return fmaxf(v, xlane_f<K>(v)); }

#ifndef REP_MIX
#define REP_MIX 1
#endif
#ifndef REP_ATT
#define REP_ATT 1
#endif
#ifndef REP_CONV
#define REP_CONV 1
#endif
#ifndef REP_P01
#define REP_P01 1
#endif
#ifndef REP_G0
#define REP_G0 1
#endif
#ifndef REP_G4
#define REP_G4 1
#endif
#ifndef REP_G2
#define REP_G2 1
#endif
#ifndef REP_G5
#define REP_G5 1
#endif
#ifndef REP_QK
#define REP_QK 1
#endif
#ifndef MK_PER_PHASE
#define MK_PER_PHASE 0
#endif

namespace pg8 {
#define PG8_LAS __attribute__((address_space(3)))
typedef unsigned short bf16_t;
typedef short bf16x8 __attribute__((ext_vector_type(8)));
typedef float f32x4 __attribute__((ext_vector_type(4)));
typedef unsigned u32x4 __attribute__((ext_vector_type(4)));
constexpr int BM = 256, BK = 64, HALF = 128, HTB = HALF * BK * 2, STAGE_BYTES = 8 * HTB, NXCD = 8, WGM = 8;

__host__ __device__ __forceinline__ int lds_byte(int r, int c) { return r * 128 + ((((c >> 3) ^ (r & 7)) << 4) | ((c & 7) * 2)); }
__host__ __device__ __forceinline__ void stage_rc(int b, int& R, int& C) { R = b >> 7; C = ((((b >> 4) & 7) ^ (R & 7)) << 3); }
__host__ __device__ __forceinline__ int perm32(int rho) { const int n = rho >> 4, i = rho & 15; return 8 * (i >> 2) + 4 * n + (i & 3); }

struct Unit { int pm, pn; };
struct Gemm { const bf16_t* A; const bf16_t* Bt; int M, N, K; size_t bvar; int lda = 0; size_t apanel = 0; };
__host__ __device__ __forceinline__ int variant_of(int pm) { return pm < 64 ? 0 : (pm < 128 ? 1 : 2); }

struct StaticOrder {
    int nM, nN, nwg, G, c;
    __host__ __device__ void init(int M, int N, int G_, int c_) { nM = M / BM; nN = N / BM; nwg = nM * nN; G = G_; c = c_; }
    __host__ __device__ bool next(int i, Unit& u) const {
        const long L = (long)i * G + c; if (L >= nwg) return false;
        int wgid = (int)L; { const int q = nwg / NXCD, r = nwg % NXCD, xcd = wgid % NXCD, off = wgid / NXCD; wgid = (xcd < r ? xcd * (q + 1) : r * (q + 1) + (xcd - r) * q) + off; }
        const int nig = WGM * nN, gid = wgid / nig, fm = gid * WGM, gsz = (nM - fm) < WGM ? (nM - fm) : WGM;
        u.pm = fm + ((wgid % nig) % gsz); u.pn = (wgid % nig) / gsz; return true;
    }
    __device__ __forceinline__ void a_ready(const Unit&) const {}
    __device__ __forceinline__ void done(const Unit&) const {}
};

__device__ __forceinline__ unsigned cvt_pk_bf16(float lo, float hi) { unsigned r; asm volatile("v_cvt_pk_bf16_f32 %0, %1, %2" : "=v"(r) : "v"(lo), "v"(hi)); return r; }

#define PG8_EPI_BAR() do { asm volatile("s_waitcnt lgkmcnt(0)" ::: "memory"); __builtin_amdgcn_s_barrier(); asm volatile("" ::: "memory"); } while (0)

struct EpiTabs { PG8_LAS int* US; PG8_LAS float* RS; PG8_LAS float* BT; PG8_LAS float* S1; PG8_LAS float* B1; };
template <class Sched> __device__ __forceinline__ void epi_tables(const Sched& S, const float* stat, const float* bias, int bias_vstride, int N, float eps, const EpiTabs& T) {
    int tid_ = threadIdx.x; asm volatile("" : "+v"(tid_)); const int tid = tid_;
    Unit u; S.next(0, u);
    const int v0 = variant_of(u.pm);
    int pm0 = -1, pm1 = -1, pm2 = -1, pm3 = -1, nslot = 0;
#pragma unroll 1
    for (int i = 0; i < 64; ++i) {
        if (!S.next(i, u)) break;
        int sl = 255;
        if (variant_of(u.pm) == v0) {
            if (u.pm == pm0) sl = 0; else if (u.pm == pm1) sl = 1; else if (u.pm == pm2) sl = 2; else if (u.pm == pm3) sl = 3;
            else if (nslot < 4) { sl = nslot; if (nslot == 0) pm0 = u.pm; else if (nslot == 1) pm1 = u.pm; else if (nslot == 2) pm2 = u.pm; else pm3 = u.pm; ++nslot; }
        }
        if (tid == 0) T.US[i] = sl;
    }
#pragma unroll 1
    for (int k = 0; k < nslot; ++k) { const int pm = k == 0 ? pm0 : (k == 1 ? pm1 : (k == 2 ? pm2 : pm3));
        if (tid < 256) { const f32x4 p = *(const f32x4*)(stat + (size_t)(pm * BM + tid) * 4); T.RS[k * 256 + tid] = 1.0f / sqrtf(((p[0] + p[1]) + (p[2] + p[3])) * (1.0f / 1024.0f) + eps); } }
    for (int idx = tid; idx < N / 4; idx += 512) *(PG8_LAS f32x4*)(T.BT + 4 * idx) = *(const f32x4*)(bias + (size_t)v0 * bias_vstride + 4 * idx);
    PG8_EPI_BAR();
}
__device__ __forceinline__ void epi_lookup(const EpiTabs& T, int ui, const Unit& u, const float* stat, const float* bias, int bias_vstride, float eps, const PG8_LAS float*& rsp, const PG8_LAS float*& btp) {
    const int slot = __builtin_amdgcn_readfirstlane(T.US[ui < 64 ? ui : 63]);
    if (ui < 64 && slot != 255) { rsp = T.RS + slot * 256; btp = T.BT + u.pn * BM; }
    else {
        int tid = threadIdx.x; asm volatile("" : "+v"(tid));
        if (tid < 256) { const f32x4 p = *(const f32x4*)(stat + (size_t)(u.pm * BM + tid) * 4); T.S1[tid] = 1.0f / sqrtf(((p[0] + p[1]) + (p[2] + p[3])) * (1.0f / 1024.0f) + eps); }
        else if (tid < 320) *(PG8_LAS f32x4*)(T.B1 + 4 * (tid - 256)) = *(const f32x4*)(bias + (size_t)variant_of(u.pm) * bias_vstride + u.pn * BM + 4 * (tid - 256));
        PG8_EPI_BAR();
        rsp = T.S1; btp = T.B1;
    }
}

template <int ACT> struct EpiNormAct {
    static constexpr bool PERM = true, AFTER_DRAIN = false;
    bf16_t* O; int ldc; const float* stat; const float* bias; int bias_vstride; int N; EpiTabs T; float eps; size_t opanel = 0;
    template <class Sched> __device__ __forceinline__ void prepare(const Sched& S) const { epi_tables(S, stat, bias, bias_vstride, N, eps, T); }
    __device__ __forceinline__ void operator()(const f32x4 (&acc)[2][2][4][2], const Unit& u, int wr, int wc, int fr, int fq, int ui) const {
        const PG8_LAS float* rsp; const PG8_LAS float* btp; epi_lookup(T, ui, u, stat, bias, bias_vstride, eps, rsp, btp);
        const int col0 = u.pn * BM + wc * 64 + 8 * fq;
        int bo = wc * 64 + 8 * fq, ro = wr * 64 + fr; asm volatile("" : "+v"(bo), "+v"(ro));
        f32x4 bv[2][2];
#pragma unroll
        for (int bj = 0; bj < 2; ++bj)
#pragma unroll
            for (int n = 0; n < 2; ++n) bv[bj][n] = *(const PG8_LAS f32x4*)(btp + bo + bj * 32 + 4 * n);
#pragma unroll
        for (int ai = 0; ai < 2; ++ai)
#pragma unroll
            for (int m = 0; m < 4; ++m) { const int rl = ai * HALF + wr * 64 + m * 16 + fr; const float rs = rsp[ro + ai * HALF + m * 16];
                bf16_t* rowp = O + (size_t)(u.pm * BM + rl) * ldc + (opanel ? (size_t)(col0 / ldc) * opanel + (col0 % ldc) : (size_t)col0);
#pragma unroll
                for (int bj = 0; bj < 2; ++bj) { f32x4 v0 = acc[ai][bj][m][0] * rs + bv[bj][0], v1 = acc[ai][bj][m][1] * rs + bv[bj][1];
                    if (ACT == 1) {
#pragma unroll
                        for (int e = 0; e < 4; ++e) { const float a = fmaxf(v0[e], 0.f), b = fmaxf(v1[e], 0.f); v0[e] = a * a; v1[e] = b * b; } }
                    u32x4 w; w.x = cvt_pk_bf16(v0[0], v0[1]); w.y = cvt_pk_bf16(v0[2], v0[3]); w.z = cvt_pk_bf16(v1[0], v1[1]); w.w = cvt_pk_bf16(v1[2], v1[3]);
                    *(u32x4*)(rowp + bj * 32) = w; } }
    }
};

constexpr size_t UPANEL = (size_t)33280 * 256;
struct EpiIn {
    static constexpr bool PERM = true, AFTER_DRAIN = false;
    bf16_t* U; const float* stat; const float* bias; const float* qg; const float* kg; const float* rope; EpiTabs T; PG8_LAS float* RT; float eps, qscale;
    template <class Sched> __device__ __forceinline__ void prepare(const Sched& S) const {
        int tid_ = threadIdx.x; asm volatile("" : "+v"(tid_));
        *(PG8_LAS f32x4*)(T.BT + 2048 + 4 * tid_) = *(const f32x4*)(rope + 4 * tid_);
        Unit u;
#pragma unroll 1
        for (int i = 0; i < 16; ++i) { if (!S.next(i, u)) break;
            if (tid_ < 128) RT[i * 128 + tid_] = rope[(size_t)((((u.pm * BM) & 16383) >> 6) + (tid_ >> 5)) * 32 + (tid_ & 31)]; }
        epi_tables(S, stat, bias, 2048, 2048, eps, T); }
    __device__ __forceinline__ void operator()(const f32x4 (&acc)[2][2][4][2], const Unit& u, int wr, int wc, int fr, int fq, int ui) const {
        const PG8_LAS float* S; const PG8_LAS float* btp; epi_lookup(T, ui, u, stat, bias, 2048, eps, S, btp);
        const int col0 = u.pn * BM + wc * 64 + 8 * fq;
        int bo = wc * 64 + 8 * fq, ro = wr * 64 + fr; asm volatile("" : "+v"(bo), "+v"(ro)); const PG8_LAS float* const Sr = S + ro;
        f32x4 bv[2][2];
#pragma unroll
        for (int bj = 0; bj < 2; ++bj)
#pragma unroll
            for (int n = 0; n < 2; ++n) bv[bj][n] = *(const PG8_LAS f32x4*)(btp + bo + bj * 32 + 4 * n);
        const bool head = (u.pn == 3 || u.pn == 4 || (u.pn == 5 && wc < 2));
        if (!head) {
#pragma unroll
            for (int ai = 0; ai < 2; ++ai)
#pragma unroll
                for (int m = 0; m < 4; ++m) { const int rl = ai * HALF + wr * 64 + m * 16 + fr; const float rs = Sr[ai * HALF + m * 16];
                    bf16_t* rowp = U + (size_t)u.pn * UPANEL + (size_t)(u.pm * BM + rl) * 256 + (col0 & 255);
#pragma unroll
                    for (int bj = 0; bj < 2; ++bj) { const f32x4 v0 = acc[ai][bj][m][0] * rs + bv[bj][0], v1 = acc[ai][bj][m][1] * rs + bv[bj][1];
                        u32x4 w; w.x = cvt_pk_bf16(v0[0], v0[1]); w.y = cvt_pk_bf16(v0[2], v0[3]); w.z = cvt_pk_bf16(v1[0], v1[1]); w.w = cvt_pk_bf16(v1[2], v1[3]);
                        *(u32x4*)(rowp + bj * 32) = w; } }
            return;
        }
        const bool isk = (u.pn == 5);
        const float* gsrc = (isk ? kg : qg) + 8 * fq; const float gmul = isk ? 1.0f : qscale;
        float gl[2][8];
#pragma unroll
        for (int bj = 0; bj < 2; ++bj)
#pragma unroll
            for (int j = 0; j < 8; ++j) gl[bj][j] = gsrc[32 * bj + j] * gmul;
        const bool upper = (fq & 2) != 0;
        int cto = 2048 + fr * 32 + 16 * (fq & 1), rto = (ui < 16 ? ui : 0) * 128 + wr * 32 + 16 * (fq & 1); asm volatile("" : "+v"(cto), "+v"(rto));
        const PG8_LAS float* const ctb = T.BT + cto; const PG8_LAS float* const rtb = RT + rto;
#pragma unroll
        for (int ai = 0; ai < 2; ++ai) {
            f32x4 q0, q1, q2, q3;
            if (ui < 16) { const PG8_LAS f32x4* rp = (const PG8_LAS f32x4*)(rtb + ai * 64); q0 = rp[0]; q1 = rp[1]; q2 = rp[2]; q3 = rp[3]; }
            else { const f32x4* rp = (const f32x4*)(rope + (size_t)((((u.pm * BM + ai * HALF + wr * 64) & 16383) >> 6) * 16 + 8 * (fq & 1)) * 2); q0 = rp[0]; q1 = rp[1]; q2 = rp[2]; q3 = rp[3]; }
            const float csr[8] = {q0[0], q0[2], q1[0], q1[2], q2[0], q2[2], q3[0], q3[2]}, snr[8] = {q0[1], q0[3], q1[1], q1[3], q2[1], q2[3], q3[1], q3[3]};
#pragma unroll
            for (int m = 0; m < 4; ++m) { const int rl = ai * HALF + wr * 64 + m * 16 + fr; const float rs = Sr[ai * HALF + m * 16]; const int row = u.pm * BM + rl;
                const PG8_LAS f32x4* cp = (const PG8_LAS f32x4*)(ctb + m * 16 * 32);
                const f32x4 c0 = cp[0], c1 = cp[1], c2 = cp[2], c3 = cp[3];
                const float csc[8] = {c0[0], c0[2], c1[0], c1[2], c2[0], c2[2], c3[0], c3[2]}, snc[8] = {c0[1], c0[3], c1[1], c1[3], c2[1], c2[3], c3[1], c3[3]};
                float ss = 0.f;
#pragma unroll
                for (int bj = 0; bj < 2; ++bj) { const f32x4 v0 = acc[ai][bj][m][0] * rs + bv[bj][0], v1 = acc[ai][bj][m][1] * rs + bv[bj][1];
                    ss += (v0[0] * v0[0] + v0[1] * v0[1]) + (v0[2] * v0[2] + v0[3] * v0[3]) + (v1[0] * v1[0] + v1[1] * v1[1]) + (v1[2] * v1[2] + v1[3] * v1[3]); }
                ss = xadd<16>(ss); ss = xadd<32>(ss);
                const float rn = __builtin_amdgcn_rsqf(ss * (1.0f / 64.0f) + eps);
                bf16_t* rowp = U + (size_t)u.pn * UPANEL + (size_t)row * 256 + (col0 & 255);
#pragma unroll
                for (int bj = 0; bj < 2; ++bj) { const f32x4 v0 = acc[ai][bj][m][0] * rs + bv[bj][0], v1 = acc[ai][bj][m][1] * rs + bv[bj][1];
                    float x[8] = {v0[0], v0[1], v0[2], v0[3], v1[0], v1[1], v1[2], v1[3]};
#pragma unroll
                    for (int j = 0; j < 8; ++j) { const float xv = x[j] * rn * gl[bj][j]; const float pv = xget32(xv, upper);
                        const float cs = bj ? csc[j] : csr[j], sn = bj ? snc[j] : snr[j];
                        x[j] = upper ? (pv * sn + xv * cs) : (xv * cs - pv * sn); }
                    u32x4 w; w.x = cvt_pk_bf16(x[0], x[1]); w.y = cvt_pk_bf16(x[2], x[3]); w.z = cvt_pk_bf16(x[4], x[5]); w.w = cvt_pk_bf16(x[6], x[7]);
                    *(u32x4*)(rowp + bj * 32) = w; } }
        }
    }
};

template <bool FINAL> struct EpiRes {
    static constexpr bool PERM = true, AFTER_DRAIN = false;
    const bf16_t* xb; bf16_t* xbo; float* out; const float* gate; int gate_vstride; float* stat_out; PG8_LAS float* P;
    template <class Sched> __device__ __forceinline__ void prepare(const Sched&) const {}
    __device__ __forceinline__ void operator()(const f32x4 (&acc)[2][2][4][2], const Unit& u, int wr, int wc, int fr, int fq, int) const {
        int tid_ = threadIdx.x; asm volatile("" : "+v"(tid_)); const int tid = tid_;
        const bf16_t* xbp = xb + (size_t)u.pm * BM * 1024; bf16_t* xop = xbo + (size_t)u.pm * BM * 1024;
        float* op = out + (size_t)u.pm * BM * 1024;
        const int col0 = u.pn * BM + wc * 64 + 8 * fq;
        int lo_ = (wr * 64 + fr) * 1024 + wc * 64 + 8 * fq; asm volatile("" : "+v"(lo_));
        const unsigned lo = (unsigned)lo_ + (unsigned)(u.pn * BM);
        const float* gp = gate + (size_t)variant_of(u.pm) * gate_vstride + col0;
        f32x4 gv[2][2];
#pragma unroll
        for (int bj = 0; bj < 2; ++bj)
#pragma unroll
            for (int n = 0; n < 2; ++n) gv[bj][n] = *(const f32x4*)(gp + bj * 32 + 4 * n);
#pragma unroll
        for (int ai = 0; ai < 2; ++ai) {
            u32x4 xr[4][2];
#pragma unroll
            for (int m = 0; m < 4; ++m)
#pragma unroll
                for (int bj = 0; bj < 2; ++bj) xr[m][bj] = *(const u32x4*)(xbp + (lo + (unsigned)((ai * HALF + m * 16) * 1024 + bj * 32)));
#pragma unroll
            for (int m = 0; m < 4; ++m) { const int rl = ai * HALF + wr * 64 + m * 16 + fr; const unsigned off = lo + (unsigned)((ai * HALF + m * 16) * 1024); float ss = 0.f;
#pragma unroll
                for (int bj = 0; bj < 2; ++bj) {
                    const u32x4 xi = xr[m][bj];
                    const f32x4 a0 = (f32x4){__uint_as_float(xi.x << 16), __uint_as_float(xi.x & 0xffff0000u), __uint_as_float(xi.y << 16), __uint_as_float(xi.y & 0xffff0000u)};
                    const f32x4 a1 = (f32x4){__uint_as_float(xi.z << 16), __uint_as_float(xi.z & 0xffff0000u), __uint_as_float(xi.w << 16), __uint_as_float(xi.w & 0xffff0000u)};
                    const f32x4 o0 = a0 + gv[bj][0] * acc[ai][bj][m][0], o1 = a1 + gv[bj][1] * acc[ai][bj][m][1];
                    if (FINAL) { *(f32x4*)(op + off + bj * 32) = o0; *(f32x4*)(op + off + bj * 32 + 4) = o1; }
                    else {
                        u32x4 w; w.x = cvt_pk_bf16(o0[0], o0[1]); w.y = cvt_pk_bf16(o0[2], o0[3]); w.z = cvt_pk_bf16(o1[0], o1[1]); w.w = cvt_pk_bf16(o1[2], o1[3]);
                        *(u32x4*)(xop + off + bj * 32) = w;
                        ss += (o0[0] * o0[0] + o0[1] * o0[1]) + (o0[2] * o0[2] + o0[3] * o0[3]) + (o1[0] * o1[0] + o1[1] * o1[1]) + (o1[2] * o1[2] + o1[3] * o1[3]); } }
                if (!FINAL) { ss = xadd<16>(ss); ss = xadd<32>(ss); if (fq == 0) P[rl * 4 + wc] = ss; } }
        }
        if (!FINAL) {
            PG8_EPI_BAR();
            if (tid < 256) { const f32x4 p = *(const PG8_LAS f32x4*)(P + tid * 4); stat_out[(size_t)(u.pm * BM + tid) * 4 + u.pn] = (p[0] + p[1]) + (p[2] + p[3]); }
        }
    }
};

template <class Epi, class Sched, bool ALIGN_EPI = false, bool SP2 = false>
__device__ __forceinline__ void gemm_phase(PG8_LAS unsigned char* lds, const Gemm g, const Sched& S, const Epi& E) {
    int tid_ = threadIdx.x; asm volatile("" : "+v"(tid_));
    const int tid = tid_, wid = __builtin_amdgcn_readfirstlane(tid >> 6), lane = tid & 63, wr = wid >> 2, wc = wid & 3, fr = lane & 15, fq = lane >> 4;
    const int K = g.K, nt = K / BK, lda = g.lda ? g.lda : g.K, ktpp = g.apanel ? lda / BK : nt; const size_t apan = g.apanel;
    unsigned voffA[2], voffB[2];
#pragma unroll
    for (int i = 0; i < 2; ++i) { int R, C; stage_rc(tid * 16 + i * 8192, R, C); const int Rb = Epi::PERM ? (64 * (R >> 5) + perm32(R & 31)) : R;
        voffA[i] = (unsigned)(R * lda + C) * 2u; voffB[i] = (unsigned)(Rb * K + C) * 2u; }
    const size_t kstep = (size_t)(BK * 2);
    const size_t hstepB = (size_t)(Epi::PERM ? 32 : HALF) * K * 2, hstepA = (size_t)HALF * lda * 2;
    const size_t tstep = (size_t)BM * K * 2, tstepA = 2 * hstepA;
    const unsigned ldsw = (unsigned)wid * 1024u;
    const int aoff = lds_byte(wr * 64 + fr, fq * 8), boff = lds_byte(wc * 32 + fr, fq * 8);
    const int aoff1 = aoff ^ 64, boff1 = boff ^ 64;
#define PG8_SA(b, h) (((b) * 2 + (h)) * HTB)
#define PG8_SB(b, h) ((4 + (b) * 2 + (h)) * HTB)
#define PG8_STAGE(bufoff, gbase, voff) do { _Pragma("unroll") for (int _i = 0; _i < 2; ++_i) \
        __builtin_amdgcn_global_load_lds((const unsigned*)((const char*)(gbase) + (voff)[_i]), (PG8_LAS unsigned*)(lds + (bufoff) + ldsw + _i * 8192), 16, 0, 0); } while (0)
#define PG8_LDA(dst, b, h) do { _Pragma("unroll") for (int m = 0; m < 4; ++m) _Pragma("unroll") for (int k = 0; k < 2; ++k) dst[m][k] = *(const PG8_LAS bf16x8*)(lds + PG8_SA(b, h) + (k ? aoff1 : aoff) + m * 2048); } while (0)
#define PG8_LDB(dst, b, h) do { _Pragma("unroll") for (int n = 0; n < 2; ++n) _Pragma("unroll") for (int k = 0; k < 2; ++k) dst[n][k] = *(const PG8_LAS bf16x8*)(lds + PG8_SB(b, h) + (k ? boff1 : boff) + n * 2048); } while (0)
#define PG8_MMA(ai, bj, At, Bt) do { __builtin_amdgcn_s_setprio(1); _Pragma("unroll") for (int m = 0; m < 4; ++m) _Pragma("unroll") for (int n = 0; n < 2; ++n) _Pragma("unroll") for (int k = 0; k < 2; ++k) \
        acc[ai][bj][m][n] = __builtin_amdgcn_mfma_f32_16x16x32_bf16(Bt[n][k], At[m][k], acc[ai][bj][m][n], 0, 0, 0); __builtin_amdgcn_s_setprio(0); } while (0)
#define PG8_WAIT_V(n) asm volatile("s_waitcnt vmcnt(" #n ")" ::: "memory")
#define PG8_WAIT_L(n) asm volatile("s_waitcnt lgkmcnt(" #n ")" ::: "memory")
#define PG8_BAR __builtin_amdgcn_s_barrier()
#define PG8_SCHED __builtin_amdgcn_sched_barrier(0)
    Unit cur, nxt; int ui = 0;
    if (!S.next(0, cur)) return;
    E.prepare(S);
    f32x4 acc[2][2][4][2];
#pragma unroll
    for (int a = 0; a < 2; ++a)
#pragma unroll
        for (int b = 0; b < 2; ++b)
#pragma unroll
            for (int m = 0; m < 4; ++m)
#pragma unroll
                for (int n = 0; n < 2; ++n) acc[a][b][m][n] = (f32x4){0.f, 0.f, 0.f, 0.f};
    bf16x8 At[4][2], B0[2][2], B1[2][2];
    const char* cA = (const char*)g.A + (size_t)cur.pm * tstepA; const char* cB = (const char*)g.Bt + (size_t)variant_of(cur.pm) * g.bvar + (size_t)cur.pn * tstep;
    S.a_ready(cur);
    if constexpr (SP2) {
        PG8_STAGE(PG8_SB(0, 0), cB, voffB); PG8_STAGE(PG8_SB(0, 1), cB + hstepB, voffB); PG8_STAGE(PG8_SA(0, 0), cA, voffA); PG8_STAGE(PG8_SA(0, 1), cA + hstepA, voffA);
        if (wr == 1) PG8_BAR;
        PG8_WAIT_V(2); PG8_BAR;
        PG8_STAGE(PG8_SB(1, 0), cB + kstep, voffB); PG8_STAGE(PG8_SA(1, 0), cA + kstep, voffA); PG8_STAGE(PG8_SB(1, 1), cB + hstepB + kstep, voffB);
        PG8_WAIT_V(6); PG8_BAR;
    } else {
        PG8_STAGE(PG8_SB(0, 0), cB, voffB); PG8_STAGE(PG8_SA(0, 0), cA, voffA); PG8_STAGE(PG8_SB(0, 1), cB + hstepB, voffB); PG8_STAGE(PG8_SA(0, 1), cA + hstepA, voffA);
        if (wr == 1) PG8_BAR;
        PG8_WAIT_V(4); PG8_BAR;
        PG8_STAGE(PG8_SB(1, 0), cB + kstep, voffB); PG8_STAGE(PG8_SA(1, 0), cA + kstep, voffA); PG8_STAGE(PG8_SB(1, 1), cB + hstepB + kstep, voffB);
        PG8_WAIT_V(6); PG8_BAR;
    }
    for (;;) {
        const bool has_next = S.next(ui + 1, nxt);
        const char* nA = has_next ? (const char*)g.A + (size_t)nxt.pm * tstepA : cA;
        const char* nB = has_next ? (const char*)g.Bt + (size_t)variant_of(nxt.pm) * g.bvar + (size_t)nxt.pn * tstep : cB;
        for (int t = 0; t < nt; t += 2) {
            const bool last = (t == nt - 2);
            const int t2 = t + 2; const size_t ak0 = (size_t)(t / ktpp) * apan + (size_t)(t % ktpp) * kstep, ak2 = (size_t)(t2 / ktpp) * apan + (size_t)(t2 % ktpp) * kstep;
            const char* a1 = cA + ak0 + kstep;
            const char* a2 = last ? nA : cA + ak2; const char* b2 = last ? nB : cB + (size_t)(t + 2) * kstep;
            const char* a3 = a2 + kstep; const char* b3 = b2 + kstep;
            if (last && has_next) S.a_ready(nxt);
            if constexpr (SP2) {
            PG8_LDB(B0, 0, 0); PG8_LDB(B1, 0, 1); PG8_SCHED; PG8_LDA(At, 0, 0); PG8_STAGE(PG8_SA(1, 1), a1 + hstepA, voffA);
            PG8_WAIT_V(8); PG8_WAIT_L(0); PG8_BAR; PG8_MMA(0, 0, At, B0); PG8_MMA(0, 1, At, B1); PG8_BAR; PG8_SCHED;
            PG8_LDA(At, 0, 1); PG8_STAGE(PG8_SB(0, 0), b2, voffB); PG8_STAGE(PG8_SB(0, 1), b2 + hstepB, voffB); PG8_STAGE(PG8_SA(0, 0), a2, voffA);
            PG8_WAIT_V(8); PG8_WAIT_L(0); PG8_BAR; PG8_MMA(1, 0, At, B0); PG8_MMA(1, 1, At, B1); PG8_BAR; PG8_SCHED;
            PG8_LDB(B0, 1, 0); PG8_LDB(B1, 1, 1); PG8_SCHED; PG8_LDA(At, 1, 0); PG8_STAGE(PG8_SA(0, 1), a2 + hstepA, voffA);
            PG8_WAIT_V(8); PG8_WAIT_L(0); PG8_BAR; PG8_MMA(0, 0, At, B0); PG8_MMA(0, 1, At, B1); PG8_BAR; PG8_SCHED;
            PG8_LDA(At, 1, 1); PG8_STAGE(PG8_SB(1, 0), b3, voffB); PG8_STAGE(PG8_SB(1, 1), b3 + hstepB, voffB); PG8_STAGE(PG8_SA(1, 0), a3, voffA);
            PG8_WAIT_V(8); PG8_WAIT_L(0); PG8_BAR; PG8_MMA(1, 0, At, B0); PG8_MMA(1, 1, At, B1); PG8_BAR; PG8_SCHED;
            } else {
            PG8_LDB(B0, 0, 0); PG8_SCHED; PG8_LDA(At, 0, 0); PG8_STAGE(PG8_SA(1, 1), a1 + hstepA, voffA);
            PG8_WAIT_L(8); PG8_BAR; PG8_WAIT_L(0); PG8_MMA(0, 0, At, B0); PG8_BAR; PG8_SCHED;
            PG8_LDB(B1, 0, 1); PG8_STAGE(PG8_SB(0, 0), b2, voffB);
            PG8_BAR; PG8_WAIT_L(0); PG8_MMA(0, 1, At, B1); PG8_BAR;
            PG8_LDA(At, 0, 1); PG8_STAGE(PG8_SA(0, 0), a2, voffA);
            PG8_BAR; PG8_WAIT_L(0); PG8_MMA(1, 0, At, B0); PG8_BAR; PG8_SCHED;
            PG8_STAGE(PG8_SB(0, 1), b2 + hstepB, voffB);
            PG8_WAIT_V(6); PG8_BAR; PG8_MMA(1, 1, At, B1); PG8_BAR;
            PG8_LDB(B0, 1, 0); PG8_SCHED; PG8_LDA(At, 1, 0); PG8_STAGE(PG8_SA(0, 1), a2 + hstepA, voffA);
            PG8_WAIT_L(8); PG8_BAR; PG8_WAIT_L(0); PG8_MMA(0, 0, At, B0); PG8_BAR; PG8_SCHED;
            PG8_LDB(B1, 1, 1); PG8_STAGE(PG8_SB(1, 0), b3, voffB);
            PG8_BAR; PG8_WAIT_L(0); PG8_MMA(0, 1, At, B1); PG8_BAR;
            PG8_LDA(At, 1, 1); PG8_STAGE(PG8_SA(1, 0), a3, voffA);
            PG8_BAR; PG8_WAIT_L(0); PG8_MMA(1, 0, At, B0); PG8_BAR; PG8_SCHED;
            PG8_STAGE(PG8_SB(1, 1), b3 + hstepB, voffB);
            PG8_WAIT_V(6); PG8_BAR; PG8_MMA(1, 1, At, B1); PG8_BAR;
            }
        }
        if constexpr (ALIGN_EPI) { if (wr == 0) PG8_BAR; }
        if constexpr (!Epi::AFTER_DRAIN) { E(acc, cur, wr, wc, fr, fq, ui); S.done(cur); }
        if (!has_next) break;
#pragma unroll
        for (int a = 0; a < 2; ++a)
#pragma unroll
            for (int b = 0; b < 2; ++b)
#pragma unroll
                for (int m = 0; m < 4; ++m)
#pragma unroll
                    for (int n = 0; n < 2; ++n) acc[a][b][m][n] = (f32x4){0.f, 0.f, 0.f, 0.f};
        cur = nxt; cA = nA; cB = nB; ++ui;
        if constexpr (ALIGN_EPI) { if (wr == 1) PG8_BAR; }
    }
    PG8_WAIT_V(0);
    if constexpr (!ALIGN_EPI) { if (wr == 0) PG8_BAR; }
    PG8_BAR;
#undef PG8_SA
#undef PG8_SB
#undef PG8_STAGE
#undef PG8_LDA
#undef PG8_LDB
#undef PG8_MMA
#undef PG8_WAIT_V
#undef PG8_WAIT_L
#undef PG8_BAR
#undef PG8_SCHED
}
}

constexpr int NWAVES = 8;
constexpr int DM = 1024, DIN = 2048, DFF = 4096, SEQ = 16384, NBATCH = 2, CTXL = 256, NLAYER = 2;
constexpr int MLAT = NBATCH * SEQ, MCTX = NBATCH * CTXL, MTOT = MLAT + MCTX;
constexpr int OFF_Q = 768, OFF_K = 1280, OFF_V = 1408, OFF_C = 1536;
constexpr size_t UPS = (size_t)MTOT * 256;
static_assert(UPS == pg8::UPANEL, "U panel size");
__host__ __device__ __forceinline__ size_t u_idx(int row, int col) { return (size_t)(col >> 8) * UPS + (size_t)row * 256 + (size_t)(col & 255); }
constexpr int NHEAD = 8, NKV = 2, HD = 64;
constexpr float EPS = 1e-6f;
constexpr int MODW = 6 * DM;
constexpr int KSPLIT = 8;
constexpr float QSCALE = 0.125f * 1.4426950408889634f;

constexpr size_t MiB = 1u << 20;
constexpr size_t WS_CTL = 0, CTL_ZERO_BYTES = 32768;
constexpr size_t WS_MODP = 1 * MiB;
constexpr size_t WS_MOD = 3 * MiB;
constexpr size_t WS_BIAS1 = 3 * MiB + 256 * 1024;
constexpr size_t WS_BIAS2 = 3 * MiB + 512 * 1024;
constexpr size_t WS_ROPE = 3 * MiB + 768 * 1024;
constexpr size_t WS_STAT1 = 4 * MiB;
constexpr size_t WS_STAT2 = 5 * MiB;
constexpr size_t WS_STATC1 = 5 * MiB + 640 * 1024;
constexpr size_t WS_STATC2 = 5 * MiB + 704 * 1024;
constexpr size_t WS_XC = 6 * MiB;
constexpr size_t WS_WIN = 8 * MiB;
constexpr size_t WS_WOUT = 32 * MiB;
constexpr size_t WS_W1 = 36 * MiB;
constexpr size_t WS_W2 = 84 * MiB;
constexpr size_t WS_XB = 100 * MiB;
constexpr size_t WS_U = 165 * MiB;
constexpr size_t WS_Y = 295 * MiB;
constexpr size_t WS_H = 165 * MiB;
constexpr size_t WS_END = 425 * MiB;
constexpr size_t WS_SCRATCH = 425 * MiB;
static_assert(WS_H + (size_t)MTOT * DFF * 2 <= WS_END && WS_Y + (size_t)MTOT * DM * 2 <= WS_END && WS_U + (size_t)MTOT * DIN * 2 <= WS_Y && WS_XB + (size_t)MTOT * DM * 2 <= WS_U, "ws map");
constexpr int CW_BAR = 4096;
static_assert((CW_BAR + 3456) * 4 <= (int)CTL_ZERO_BYTES, "barrier words inside the per-call memset");

constexpr int RING_OFF = 0, RING_BYTES = 131072;
constexpr int LDSCTL_OFF = RING_BYTES, MISC_OFF = LDSCTL_OFF + 320;
constexpr int EPI_US_OFF = RING_BYTES + 512;
constexpr int EPI_S_OFF = RING_BYTES + 1024;
constexpr int EPI_P_OFF = RING_BYTES + 2048;
constexpr int EPI_RS_OFF = RING_BYTES + 10240;
constexpr int EPI_BT_OFF = RING_BYTES + 14336;
constexpr int EPI_B1_OFF = RING_BYTES + 30720;
constexpr int EPI_RT_OFF = RING_BYTES + 31744;
constexpr int LDS_BYTES = RING_BYTES + 32256;
static_assert(EPI_P_OFF + 8192 <= EPI_RS_OFF && LDS_BYTES <= 163840, "LDS map");

#define GAS __attribute__((address_space(1)))
#define LAS __attribute__((address_space(3)))
typedef unsigned short bf16;
typedef unsigned v4u __attribute__((ext_vector_type(4)));
typedef unsigned v2u __attribute__((ext_vector_type(2)));
typedef float f32x4 __attribute__((ext_vector_type(4)));
typedef GAS unsigned gu32;
#define RLX_AGENT __ATOMIC_RELAXED, __HIP_MEMORY_SCOPE_AGENT
#define LDS_WAIT() asm volatile("s_waitcnt lgkmcnt(0)" ::: "memory")
typedef float f32x2_t __attribute__((ext_vector_type(2)));
typedef __bf16 bf16x2_t __attribute__((ext_vector_type(2)));
__device__ __forceinline__ unsigned pk2(float lo, float hi) { f32x2_t v = {lo, hi}; bf16x2_t b = __builtin_convertvector(v, bf16x2_t); return __builtin_bit_cast(unsigned, b); }
__device__ __forceinline__ unsigned f2bf(float f) { return pk2(f, 0.f) & 0xffffu; }
__device__ __forceinline__ float bflo(unsigned w) { return __builtin_bit_cast(float, w << 16); }
__device__ __forceinline__ float bfhi(unsigned w) { return __builtin_bit_cast(float, w & 0xffff0000u); }
__device__ __forceinline__ float bf1(bf16 h) { return __builtin_bit_cast(float, (unsigned)h << 16); }
__device__ __forceinline__ float sigmoidf_(float v) { return __builtin_amdgcn_rcpf(1.0f + __expf(-v)); }

#define XB_TMO      128
#define XB_XCNT(j)  (256  + 64 * (j))
#define XB_XSUB(j)  (1280 + 64 * (j))
#define XB_XGEN(j)  (2304 + 64 * (j))
#define XB_TOP      3328
#define XB_TOPGEN   3392
#define XCD_BAR_WORDS 3456
#define XB_SPIN_CAP (1u << 18)
__device__ __forceinline__ unsigned xb_ld(unsigned* p)              { return __hip_atomic_load(p, __ATOMIC_RELAXED, __HIP_MEMORY_SCOPE_AGENT); }
__device__ __forceinline__ unsigned xb_add(unsigned* p, unsigned v) { return __hip_atomic_fetch_add(p, v, __ATOMIC_RELAXED, __HIP_MEMORY_SCOPE_AGENT); }
__device__ __forceinline__ unsigned xb_xcc_id() { return (unsigned)__builtin_amdgcn_s_getreg((3 << 11) | 20) & 0xFu; }
#define XB_SPIN(cond, bar) do { unsigned _sp = 0; while (cond) { __builtin_amdgcn_s_sleep(1); \
    if ((++_sp & 255u) == 0u) { if (xb_ld(&(bar)[XB_TMO])) break; if (_sp > XB_SPIN_CAP) { atomicAdd(&(bar)[XB_TMO], 1u); break; } } } } while (0)
struct XcdBarrier { unsigned* bar; unsigned x; volatile LAS unsigned* st; };
__device__ __forceinline__ XcdBarrier xcd_barrier_post(unsigned* bar, volatile LAS unsigned* st) {
    XcdBarrier b; b.bar = bar; b.x = xb_xcc_id(); b.st = st;
    if (threadIdx.x == 0) (void)xb_add(&bar[XB_XCNT(b.x)], 1u);
    return b;
}
__device__ __forceinline__ void xcd_barrier_complete(unsigned* bar, unsigned x, unsigned& nloc, unsigned& nx) {
    const unsigned G = gridDim.x * gridDim.y * gridDim.z;
    unsigned sum, cnt, mine, sp = 0u;
    for (;;) {
        sum = 0u; cnt = 0u; mine = 0u;
#pragma unroll
        for (unsigned j = 0; j < 16; ++j) { const unsigned c = xb_ld(&bar[XB_XCNT(j)]); sum += c; cnt += (c > 0u) ? 1u : 0u; mine = (j == x) ? c : mine; }
        if (sum == G) break;
        __builtin_amdgcn_s_sleep(1);
        if ((++sp & 255u) == 0u) { if (xb_ld(&bar[XB_TMO])) break; if (sp > XB_SPIN_CAP) { atomicAdd(&bar[XB_TMO], 1u); break; } }
    }
    nloc = mine > 0u ? mine : 1u; nx = cnt > 0u ? cnt : 1u;
}
__device__ __forceinline__ void xcd_barrier(const XcdBarrier& b) {
    asm volatile("s_waitcnt vmcnt(0)" ::: "memory");
    __syncthreads();
    if (threadIdx.x == 0) {
        unsigned* bar = b.bar;
        __builtin_amdgcn_s_waitcnt(0);
        unsigned nloc = b.st[0], nx = b.st[1];
        if (nloc == 0u) { xcd_barrier_complete(bar, b.x, nloc, nx); b.st[0] = nloc; b.st[1] = nx; }
        const unsigned old = xb_add(&bar[XB_XSUB(b.x)], 1u);
        const unsigned gen = old / nloc;
        if (old + 1u == (gen + 1u) * nloc) {
            __builtin_amdgcn_fence(__ATOMIC_RELEASE, "agent");
            asm volatile("s_waitcnt vmcnt(0)" ::: "memory");
            const unsigned og = xb_add(&bar[XB_TOP], 1u);
            const unsigned tg = og / nx;
            if (og + 1u == (tg + 1u) * nx) xb_add(&bar[XB_TOPGEN], 1u);
            else XB_SPIN(xb_ld(&bar[XB_TOPGEN]) == tg, bar);
            __builtin_amdgcn_fence(__ATOMIC_ACQUIRE, "agent");
            xb_add(&bar[XB_XGEN(b.x)], 1u);
            asm volatile("s_waitcnt vmcnt(0)" ::: "memory");
        } else {
            XB_SPIN(xb_ld(&bar[XB_XGEN(b.x)]) == gen, bar);
            __builtin_amdgcn_fence(__ATOMIC_ACQUIRE, "agent");
            asm volatile("s_waitcnt vmcnt(0)" ::: "memory");
        }
    }
    __syncthreads();
}

struct Args {
    const float* in[20]; float* out; unsigned char* ws; int ph_lo, ph_hi;
};
struct Frame {
    LAS unsigned char* lds;
    int tid, lane, wave, vcu, G;
    const float *x, *c, *ctx, *c_ctx, *w_mod, *b_mod, *norm1_g, *w_in, *conv_a_w, *q_norm_g, *k_norm_g, *attn_sink, *conv_c_w, *conv_c_b, *ln_c_g, *ln_c_b, *w_out, *norm2_g, *w_mlp1, *w_mlp2;
    float* out;
    float *modp, *mod, *bias1, *bias2, *rope, *stat1, *stat2, *statc1, *statc2, *xc;
    bf16 *win_t, *wout_t, *w1_t, *w2_t, *xb, *u, *y, *h;
};

__device__ __forceinline__ float wave_sum(float v) { v = xadd<1>(v); v = xadd<2>(v); v = xadd<4>(v); v = xadd<8>(v); v = xadd<16>(v); return xadd<32>(v); }

__device__ __forceinline__ void sincos_d(double x, double& s, double& c) {
    const double TWO_PI = 6.283185307179586476925286766559;
    const double k = rint(x / TWO_PI); const double r = x - k * TWO_PI, r2 = r * r;
    double ts = r, tc = 1.0; s = r; c = 1.0;
#pragma unroll 1
    for (int i = 1; i <= 18; ++i) { tc *= -r2 / (double)((2 * i - 1) * (2 * i)); c += tc; ts *= -r2 / (double)((2 * i) * (2 * i + 1)); s += ts; }
}
__device__ __forceinline__ void p0_phase(Frame& F) {
    LAS float* sl = (LAS float*)(F.lds + RING_OFF);
    for (int item = blockIdx.x; item < NLAYER * KSPLIT * 12; item += F.G) {
        const int l = item / (KSPLIT * 12), rr = item % (KSPLIT * 12), ks = rr / 12, cc = rr % 12, n = cc * 512 + F.tid;
        __syncthreads();
        if (F.tid < 384) { const int r = F.tid >> 7, kk = F.tid & 127; const float cv = (r < 2) ? F.c[r * DM + ks * 128 + kk] : F.c_ctx[ks * 128 + kk]; sl[F.tid] = cv / (1.0f + expf(-cv)); }
        __syncthreads();
        const float* W = F.w_mod + (size_t)l * DM * MODW + (size_t)(ks * 128) * MODW + n;
        float a0 = 0.f, a1 = 0.f, a2 = 0.f;
#pragma unroll 8
        for (int kk = 0; kk < 128; ++kk) { const float w = W[(size_t)kk * MODW]; a0 += sl[kk] * w; a1 += sl[128 + kk] * w; a2 += sl[256 + kk] * w; }
        float* o = F.modp + ((size_t)(ks * NLAYER + l) * 3) * MODW + n;
        o[0] = a0; o[MODW] = a1; o[2 * MODW] = a2;
    }
    __syncthreads();
    const int gw = F.vcu * NWAVES + F.wave, NGW = F.G * NWAVES;
    const bool bal0 = (F.G == 256); const int bx0 = (int)blockIdx.x;
    const int nb0 = bal0 ? 15 : 0x7fffffff, xw0 = (bal0 && bx0 >= 192 && bx0 < 255) ? (bx0 - 192) * NWAVES + F.wave : -1;
    for (int n0_ = 0; ; ++n0_) {
        int row; if (n0_ < nb0) row = gw + n0_ * NGW; else if (xw0 >= 0) row = 15 * NGW + xw0 + (n0_ - nb0) * (63 * NWAVES); else break;
        if (row >= MTOT) break;
        const float* src = (row < MLAT) ? F.x + (size_t)row * DM : F.ctx + (size_t)(row - MLAT) * DM;
        const f32x4* xr = (const f32x4*)src + F.lane;
        f32x4 v[4]; float q[4];
#pragma unroll
        for (int j = 0; j < 4; ++j) { v[j] = xr[64 * j]; q[j] = wave_sum((v[j].x * v[j].x + v[j].y * v[j].y) + (v[j].z * v[j].z + v[j].w * v[j].w)); }
        unsigned long long* o8 = (unsigned long long*)(F.xb + (size_t)row * DM) + F.lane;
#pragma unroll
        for (int j = 0; j < 4; ++j) o8[64 * j] = (unsigned long long)pk2(v[j].x, v[j].y) | ((unsigned long long)pk2(v[j].z, v[j].w) << 32);
        if (F.lane == 0) *(f32x4*)(F.stat1 + (size_t)row * 4) = (f32x4){q[0], q[1], q[2], q[3]};
        if (row >= MLAT) {
#pragma unroll
            for (int j = 0; j < 4; ++j) { float p = (v[j].x * v[j].x + v[j].y * v[j].y) + (v[j].z * v[j].z + v[j].w * v[j].w);
                p = xadd<1>(p); p = xadd<2>(p); p = xadd<4>(p); p = xadd<8>(p);
                if ((F.lane & 15) == 0) F.statc1[(size_t)(row - MLAT) * 16 + 4 * j + (F.lane >> 4)] = p; }
        }
    }
    if (blockIdx.x == F.G - 1) {
        const float inv_freq[16] = {1.0f, 0.5623413324356079f, 0.3162277638912201f, 0.17782793939113617f, 0.10000000149011612f, 0.05623413249850273f, 0.03162277489900589f, 0.017782794311642647f,
                                    0.009999999776482582f, 0.005623413249850273f, 0.003162277629598975f, 0.0017782794311642647f, 0.0010000000474974513f, 0.000562341301701963f, 0.0003162277571391314f, 0.00017782794020604342f};
        for (int idx = F.tid; idx < 256 * 16; idx += NWAVES * 64) {
            const int pos = idx >> 4, i = idx & 15;
            float fr = 1.0f;
#pragma unroll
            for (int j = 0; j < 16; ++j) fr = (i == j) ? inv_freq[j] : fr;
            const float ang = (float)pos * fr; double s, c; sincos_d((double)ang, s, c);
            F.rope[idx * 2] = (float)c; F.rope[idx * 2 + 1] = (float)s;
        }
    }
}

__device__ __forceinline__ void p1_transpose_item(Frame& F, const float* W, int K, int N, bf16* WT, size_t vstride, int nvar, const float* gvec, int layer, int scoff, LAS float* scr, int item) {
    const int lane = F.lane;
    const int nblk = N / 32, kb = item / nblk, nb = item % nblk, k0 = 64 * kb, n0 = 32 * nb;
    LAS float* gsl = scr + 64 * 33;
#pragma unroll 8
    for (int i = 0; i < 32; ++i) { const int kk = 2 * i + (lane >> 5); scr[kk * 33 + (lane & 31)] = W[(size_t)(k0 + kk) * N + n0 + (lane & 31)]; }
    if (gvec) {
        const float g = gvec[k0 + lane];
#pragma unroll
        for (int v = 0; v < 3; ++v) { float s = F.b_mod[layer * MODW + scoff + k0 + lane];
#pragma unroll
            for (int p = 0; p < KSPLIT; ++p) s += F.modp[((size_t)(p * NLAYER + layer) * 3 + v) * MODW + scoff + k0 + lane];
            gsl[v * 64 + lane] = g * (1.0f + s); }
    }
    LDS_WAIT(); asm volatile("" ::: "memory");
    const int c = lane & 7;
    for (int v = 0; v < nvar; ++v) {
        float sc[8];
#pragma unroll
        for (int e = 0; e < 8; ++e) sc[e] = gvec ? gsl[v * 64 + 8 * c + e] : 1.0f;
#pragma unroll
        for (int j = 0; j < 4; ++j) { const int n = (lane >> 3) + 8 * j; const LAS float* s = scr + (8 * c) * 33 + n;
            v4u o; o.x = pk2(s[0 * 33] * sc[0], s[1 * 33] * sc[1]); o.y = pk2(s[2 * 33] * sc[2], s[3 * 33] * sc[3]); o.z = pk2(s[4 * 33] * sc[4], s[5 * 33] * sc[5]); o.w = pk2(s[6 * 33] * sc[6], s[7 * 33] * sc[7]);
            *(v4u*)(WT + (size_t)v * vstride + (size_t)(n0 + n) * K + k0 + 8 * c) = o; }
    }
    LDS_WAIT(); asm volatile("" ::: "memory");
}
__device__ __forceinline__ void p1_phase(Frame& F) {
    {
        LAS float* shl = (LAS float*)(F.lds + RING_OFF);
        LAS float* red = shl + 3 * 1024;
        for (int item = blockIdx.x; item < NLAYER * 96; item += F.G) {
            const int l = item / 96, j = item % 96; const bool is_in = j < 32;
            const int N = is_in ? DIN : DFF, c0 = (is_in ? j : j - 32) * 64, shoff = is_in ? 0 : 3 * DM;
            const float* W = (is_in ? F.w_in + (size_t)l * DM * DIN : F.w_mlp1 + (size_t)l * DM * DFF);
            __syncthreads();
            for (int idx = F.tid; idx < 3 * 1024; idx += NWAVES * 64) { const int v = idx >> 10, k = idx & 1023; float s = F.b_mod[l * MODW + shoff + k];
#pragma unroll
                for (int p = 0; p < KSPLIT; ++p) s += F.modp[((size_t)(p * NLAYER + l) * 3 + v) * MODW + shoff + k];
                shl[idx] = s; }
            __syncthreads();
            const int col = F.tid & 63, kg = F.tid >> 6;
            const float* Wp = W + (size_t)(kg * 128) * N + c0 + col;
            float a0 = 0.f, a1 = 0.f, a2 = 0.f;
#pragma unroll 8
            for (int kk = 0; kk < 128; ++kk) { const float w = Wp[(size_t)kk * N]; const int k = kg * 128 + kk; a0 += shl[k] * w; a1 += shl[1024 + k] * w; a2 += shl[2048 + k] * w; }
            red[(kg * 3 + 0) * 64 + col] = a0; red[(kg * 3 + 1) * 64 + col] = a1; red[(kg * 3 + 2) * 64 + col] = a2;
            __syncthreads();
            if (F.tid < 192) { const int v = F.tid >> 6, cc = F.tid & 63; float s = 0.f;
#pragma unroll
                for (int g = 0; g < 8; ++g) s += red[(g * 3 + v) * 64 + cc];
                float* dst = is_in ? F.bias1 + ((size_t)l * 3 + v) * DIN : F.bias2 + ((size_t)l * 3 + v) * DFF;
                dst[c0 + cc] = s; }
        }
        __syncthreads();
    }
    for (int idx = blockIdx.x * (NWAVES * 64) + F.tid; idx < NLAYER * 3 * MODW; idx += F.G * NWAVES * 64) {
        const int l = idx / (3 * MODW), rem = idx % (3 * MODW), v = rem / MODW, n = rem % MODW;
        float s = F.b_mod[l * MODW + n];
#pragma unroll
        for (int p = 0; p < KSPLIT; ++p) s += F.modp[((size_t)(p * NLAYER + l) * 3 + v) * MODW + n];
        F.mod[idx] = s;
    }
    LAS float* scr = (LAS float*)(F.lds + RING_OFF + F.wave * 16384);
    const int gw = F.vcu * NWAVES + F.wave, NGW = F.G * NWAVES;
    constexpr int I_IN = (DM / 64) * (DIN / 32), I_1 = (DM / 64) * (DFF / 32), I_O = (DM / 64) * (DM / 32), I_2 = (DFF / 64) * (DM / 32), I_L = I_IN + I_1 + I_O + I_2;
    const bool bal1 = (F.G == 256) && (NLAYER * I_L == 11264); const int bx1 = (int)blockIdx.x;
    const int nb1 = bal1 ? 5 : 0x7fffffff, xw1 = (bal1 && bx1 >= 192) ? (bx1 - 192) * NWAVES + F.wave : -1;
    for (int n1_ = 0; ; ++n1_) {
        int it; if (n1_ < nb1) it = gw + n1_ * NGW; else if (xw1 >= 0) it = 5 * NGW + xw1 + (n1_ - nb1) * (64 * NWAVES); else break;
        if (it >= NLAYER * I_L) break;
        const int l = it / I_L; int r = it % I_L;
        if (r < I_IN) { p1_transpose_item(F, F.w_in + (size_t)l * DM * DIN, DM, DIN, F.win_t + (size_t)l * 3 * DIN * DM, (size_t)DIN * DM, 3, F.norm1_g + l * DM, l, 1 * DM, scr, r); continue; } r -= I_IN;
        if (r < I_1) { p1_transpose_item(F, F.w_mlp1 + (size_t)l * DM * DFF, DM, DFF, F.w1_t + (size_t)l * 3 * DFF * DM, (size_t)DFF * DM, 3, F.norm2_g + l * DM, l, 4 * DM, scr, r); continue; } r -= I_1;
        if (r < I_O) { p1_transpose_item(F, F.w_out + (size_t)l * DM * DM, DM, DM, F.wout_t + (size_t)l * DM * DM, 0, 1, nullptr, l, 0, scr, r); continue; } r -= I_O;
        p1_transpose_item(F, F.w_mlp2 + (size_t)l * DFF * DM, DFF, DM, F.w2_t + (size_t)l * DM * DFF, 0, 1, nullptr, l, 0, scr, r);
    }
}

typedef short cg_bf16x8 __attribute__((ext_vector_type(8)));
template <int MODE> __device__ __forceinline__ void ctx_gemm(Frame& F, const bf16* A, const bf16* Bt, int K, int ct0, int nct,
                                                            bf16* O, int ldo, const float* stat_in, const float* vecp  ,
                                                            const float* xi, float* xo, float* stat_out, const float* hnq = nullptr, const float* hnk = nullptr) {
    const int lane = F.lane, wave = F.wave, tid = F.tid, fr = lane & 15, fq = lane >> 4;
    LAS float* red = (LAS float*)(F.lds + RING_OFF);
    const int kslice = K / NWAVES;
    for (int it = blockIdx.x; it < 8 * nct; it += F.G) {
        const int rt = it & 7, ct = ct0 + (it >> 3), r0 = rt * 64, n0 = ct * 64;
        f32x4 acc[4][4];
#pragma unroll
        for (int mi = 0; mi < 4; ++mi)
#pragma unroll
            for (int ni = 0; ni < 4; ++ni) acc[mi][ni] = (f32x4){0.f, 0.f, 0.f, 0.f};
        const bf16* ap = A + (size_t)(r0 + fr) * K + wave * kslice + 8 * fq;
        const bf16* bp = Bt + (size_t)(n0 + fr) * K + wave * kslice + 8 * fq;
#pragma unroll 1
        for (int kc = 0; kc < kslice; kc += 128) {
            cg_bf16x8 af[4][4], bf[4][4];
#pragma unroll
            for (int kk = 0; kk < 4; ++kk)
#pragma unroll
                for (int i = 0; i < 4; ++i) { af[kk][i] = *(const cg_bf16x8*)(ap + (size_t)(16 * i) * K + kc + 32 * kk); bf[kk][i] = *(const cg_bf16x8*)(bp + (size_t)(16 * i) * K + kc + 32 * kk); }
#pragma unroll
            for (int kk = 0; kk < 4; ++kk)
#pragma unroll
                for (int mi = 0; mi < 4; ++mi)
#pragma unroll
                    for (int ni = 0; ni < 4; ++ni) acc[mi][ni] = __builtin_amdgcn_mfma_f32_16x16x32_bf16(bf[kk][ni], af[kk][mi], acc[mi][ni], 0, 0, 0);
        }
        __syncthreads();
#pragma unroll
        for (int mi = 0; mi < 4; ++mi)
#pragma unroll
            for (int ni = 0; ni < 4; ++ni) *(LAS f32x4*)(red + wave * 4096 + (16 * mi + fr) * 64 + 16 * ni + 4 * fq) = acc[mi][ni];
        __syncthreads();
        const int rl = tid >> 3, c8 = (tid & 7) * 8, row = r0 + rl, col = n0 + c8;
        f32x4 v0 = (f32x4){0.f, 0.f, 0.f, 0.f}, v1 = v0;
#pragma unroll
        for (int w = 0; w < NWAVES; ++w) { v0 += *(const LAS f32x4*)(red + w * 4096 + rl * 64 + c8); v1 += *(const LAS f32x4*)(red + w * 4096 + rl * 64 + c8 + 4); }
        if (MODE == 0 || MODE == 2) {
            float ss = 0.f;
#pragma unroll
            for (int j = 0; j < 4; ++j) { const f32x4 p = *(const f32x4*)(stat_in + (size_t)row * 16 + 4 * j); ss += (p[0] + p[1]) + (p[2] + p[3]); }
            const float rs = 1.0f / sqrtf(ss * (1.0f / 1024.0f) + EPS);
            const f32x4 b0 = *(const f32x4*)(vecp + col), b1 = *(const f32x4*)(vecp + col + 4);
            v0 = v0 * rs + b0; v1 = v1 * rs + b1;
            if (MODE == 0 && hnq != nullptr && ct >= OFF_Q / 64 && ct < OFF_V / 64) {
                float ss = (v0[0] * v0[0] + v0[1] * v0[1]) + (v0[2] * v0[2] + v0[3] * v0[3]) + (v1[0] * v1[0] + v1[1] * v1[1]) + (v1[2] * v1[2] + v1[3] * v1[3]);
                ss = xadd<1>(ss); ss = xadd<2>(ss); ss = xadd<4>(ss);
                const float rn = 1.0f / sqrtf(ss * (1.0f / 64.0f) + EPS);
                const bool isq = ct < OFF_K / 64; const float* gp = (isq ? hnq : hnk) + c8; const float gm = isq ? QSCALE * rn : rn;
                const f32x4 g0 = *(const f32x4*)gp, g1 = *(const f32x4*)(gp + 4);
                v0 = v0 * g0 * gm; v1 = v1 * g1 * gm;
            }
            if (MODE == 2) {
#pragma unroll
                for (int e = 0; e < 4; ++e) { const float a = fmaxf(v0[e], 0.f), b = fmaxf(v1[e], 0.f); v0[e] = a * a; v1[e] = b * b; } }
            v4u w; w.x = pk2(v0[0], v0[1]); w.y = pk2(v0[2], v0[3]); w.z = pk2(v1[0], v1[1]); w.w = pk2(v1[2], v1[3]);
            if (MODE == 0) *(v4u*)(O + u_idx(MLAT + row, col)) = w;
            else *(v4u*)(O + (size_t)(MLAT + row) * ldo + col) = w;
        } else {
            const f32x4 g0 = *(const f32x4*)(vecp + col), g1 = *(const f32x4*)(vecp + col + 4);
            const f32x4 a0 = *(const f32x4*)(xi + (size_t)row * DM + col), a1 = *(const f32x4*)(xi + (size_t)row * DM + col + 4);
            const f32x4 o0 = a0 + g0 * v0, o1 = a1 + g1 * v1;
            *(f32x4*)(xo + (size_t)row * DM + col) = o0; *(f32x4*)(xo + (size_t)row * DM + col + 4) = o1;
            v4u w; w.x = pk2(o0[0], o0[1]); w.y = pk2(o0[2], o0[3]); w.z = pk2(o1[0], o1[1]); w.w = pk2(o1[2], o1[3]);
            *(v4u*)(O + (size_t)(MLAT + row) * ldo + col) = w;
            float ss = (o0[0] * o0[0] + o0[1] * o0[1]) + (o0[2] * o0[2] + o0[3] * o0[3]) + (o1[0] * o1[0] + o1[1] * o1[1]) + (o1[2] * o1[2] + o1[3] * o1[3]);
            ss = xadd<1>(ss); ss = xadd<2>(ss); ss = xadd<4>(ss);
            if ((tid & 7) == 0) stat_out[(size_t)row * 16 + ct] = ss;
        }
    }
    __syncthreads();
}

constexpr int CV_OB = 65536 + 1024;
constexpr int CV_ST = CV_OB + 64 * 256 * 2;
static_assert(94 * 256 * 4 <= RING_BYTES && CV_ST + 512 <= RING_BYTES, "conv LDS map");
__device__ __forceinline__ void unpack8(const v4u w, float (&f)[8]) { f[0] = bflo(w.x); f[1] = bfhi(w.x); f[2] = bflo(w.y); f[3] = bfhi(w.y); f[4] = bflo(w.z); f[5] = bfhi(w.z); f[6] = bflo(w.w); f[7] = bfhi(w.w); }
__device__ __forceinline__ void conv_tile(Frame& F, int layer, int ti) {
    const int tid = F.tid, r0 = ti * 64;
    int s0, s1;
    if (r0 < MLAT) { s0 = r0 & ~(SEQ - 1); s1 = s0 + SEQ; } else { s0 = MLAT + ((r0 - MLAT) & ~(CTXL - 1)); s1 = s0 + CTXL; }
    LAS float* zl = (LAS float*)(F.lds + RING_OFF);
    LAS bf16* ob = (LAS bf16*)(F.lds + RING_OFF + CV_OB);
    LAS float* st = (LAS float*)(F.lds + RING_OFF + CV_ST);
    int cg_ = tid & 31; asm volatile("" : "+v"(cg_)); const int cg = cg_;
    const char* ub = (const char*)F.u; constexpr unsigned UPB = (unsigned)(UPS * 2);
    v4u zv[6], zg[6]; bool zok[6];
#pragma unroll
    for (int i = 0; i < 6; ++i) { const int rr = (tid >> 5) + 16 * i, row = r0 - 15 + rr; zok[i] = (rr < 94) && (row >= s0) && (row < s1);
        const unsigned off = (unsigned)(OFF_C / 256) * UPB + (unsigned)(zok[i] ? row : r0) * 512u + (unsigned)(16 * cg); zv[i] = *(const v4u*)(ub + off); zg[i] = *(const v4u*)(ub + off + UPB); }
    const int rb = r0 + 4 * (tid >> 5);
    v4u ax[6], ac[6]; bool aok[6];
#pragma unroll
    for (int k = 0; k < 6; ++k) { const int row = rb - 1 + k; aok[k] = (row >= s0) && (row < s1);
        const unsigned off = (unsigned)(aok[k] ? row : r0) * 512u + (unsigned)(16 * cg); ax[k] = *(const v4u*)(ub + off); ac[k] = *(const v4u*)(ub + off + 2u * UPB); }
    __syncthreads();
#pragma unroll
    for (int i = 0; i < 6; ++i) { const int rr = (tid >> 5) + 16 * i; float a[8], g[8]; unpack8(zv[i], a); unpack8(zg[i], g);
        f32x4 z0, z1;
#pragma unroll
        for (int e = 0; e < 4; ++e) { z0[e] = zok[i] ? a[e] * sigmoidf_(g[e]) : 0.f; z1[e] = zok[i] ? a[4 + e] * sigmoidf_(g[4 + e]) : 0.f; }
        if (rr < 94) { *(LAS f32x4*)(zl + rr * 256 + 8 * cg) = z0; *(LAS f32x4*)(zl + rr * 256 + 8 * cg + 4) = z1; } }
    {
        v4u ab[4];
#pragma unroll
        for (int k = 0; k < 4; ++k) ab[k] = *(const v4u*)(ub + UPB + (unsigned)(rb + k) * 512u + (unsigned)(16 * cg));
        const float* wa = F.conv_a_w + (size_t)layer * 3 * 256 + 8 * cg;
        float w0[8], w1[8], w2[8];
#pragma unroll
        for (int e = 0; e < 8; ++e) { w0[e] = wa[e]; w1[e] = wa[256 + e]; w2[e] = wa[512 + e]; }
        float pm[8], pc[8], pn[8];
        { float x[8], c[8]; unpack8(ax[0], x); unpack8(ac[0], c);
#pragma unroll
          for (int e = 0; e < 8; ++e) pm[e] = aok[0] ? x[e] * c[e] : 0.f;
          unpack8(ax[1], x); unpack8(ac[1], c);
#pragma unroll
          for (int e = 0; e < 8; ++e) pc[e] = aok[1] ? x[e] * c[e] : 0.f; }
#pragma unroll
        for (int k = 0; k < 4; ++k) { float x[8], c[8], b[8]; unpack8(ax[k + 2], x); unpack8(ac[k + 2], c); unpack8(ab[k], b);
#pragma unroll
            for (int e = 0; e < 8; ++e) pn[e] = aok[k + 2] ? x[e] * c[e] : 0.f;
            float y[8];
#pragma unroll
            for (int e = 0; e < 8; ++e) y[e] = b[e] * (w0[e] * pm[e] + w1[e] * pc[e] + w2[e] * pn[e]);
            v4u o; o.x = pk2(y[0], y[1]); o.y = pk2(y[2], y[3]); o.z = pk2(y[4], y[5]); o.w = pk2(y[6], y[7]);
            *(v4u*)(F.y + (size_t)(rb + k) * DM + 8 * cg) = o;
#pragma unroll
            for (int e = 0; e < 8; ++e) { pm[e] = pc[e]; pc[e] = pn[e]; } }
    }
    __syncthreads();
    int c_ = tid & 255; asm volatile("" : "+v"(c_));
    const int c = c_, half = tid >> 8;
    float acc[32];
    {
        float w[31];
#pragma unroll
        for (int j = 0; j < 31; ++j) w[j] = F.conv_c_w[(size_t)layer * 31 * 256 + j * 256 + c];
        const float bias = F.conv_c_b[layer * 256 + c];
#pragma unroll
        for (int i = 0; i < 32; ++i) acc[i] = bias;
#pragma unroll
        for (int r = 0; r < 62; ++r) { const float zv1 = zl[(half * 32 + r) * 256 + c];
#pragma unroll
            for (int i = 0; i < 32; ++i) { const int j = r - i; if (j >= 0 && j <= 30) acc[i] += w[j] * zv1; } }
    }
    __syncthreads();
#pragma unroll
    for (int i = 0; i < 32; ++i) zl[(half * 32 + i) * 256 + c] = acc[i];
    __syncthreads();
    {
        const int t = tid >> 3, part = tid & 7, lane = tid & 63; float sm = 0.f;
#pragma unroll 8
        for (int i = 0; i < 32; ++i) sm += zl[t * 256 + part * 32 + ((i + lane) & 31)];
        sm = xadd<1>(sm); sm = xadd<2>(sm); sm = xadd<4>(sm);
        const float mean = sm * (1.0f / 256.0f); float q = 0.f;
#pragma unroll 8
        for (int i = 0; i < 32; ++i) { const float d = zl[t * 256 + part * 32 + ((i + lane) & 31)] - mean; q += d * d; }
        q = xadd<1>(q); q = xadd<2>(q); q = xadd<4>(q);
        if (part == 0) { st[t * 2] = mean; st[t * 2 + 1] = 1.0f / sqrtf(q * (1.0f / 256.0f) + EPS); }
    }
    __syncthreads();
    {
        const float g = F.ln_c_g[layer * 256 + c], be = F.ln_c_b[layer * 256 + c];
#pragma unroll
        for (int i = 0; i < 32; ++i) { const int t = half * 32 + i; const float v = (acc[i] - st[t * 2]) * st[t * 2 + 1] * g + be;
            ob[t * 256 + c] = (bf16)f2bf(v * sigmoidf_(v)); }
    }
    __syncthreads();
#pragma unroll
    for (int i = 0; i < 4; ++i) { const int row = (tid >> 5) + 16 * i; const v4u v = *(const LAS v4u*)(ob + row * 256 + 8 * cg); *(v4u*)(F.y + (size_t)(r0 + row) * DM + 768 + 8 * cg) = v; }
}

typedef float f32x16 __attribute__((ext_vector_type(16)));
typedef short bf16x8_t __attribute__((ext_vector_type(8)));
typedef short s16x4_t __attribute__((ext_vector_type(4)));
constexpr int KSTR = 144, VSTR = 192;
constexpr int ATT_VA = 384 * KSTR, ATT_VB = 256 * KSTR;
constexpr int ATT_OST = 256 * KSTR + 256 * VSTR;
constexpr int ATT_LW = ATT_OST + 8 * 4096;
static_assert(ATT_VA + 384 * VSTR <= RING_BYTES && ATT_LW + 8 * 256 <= RING_BYTES, "attention LDS map");
__device__ __forceinline__ int crow(int r, int hi) { return (r & 3) + 8 * (r >> 2) + 4 * hi; }
__device__ __forceinline__ unsigned cvtpk_s(float lo, float hi) { f32x2_t v = {lo, hi}; bf16x2_t b = __builtin_convertvector(v, bf16x2_t); return __builtin_bit_cast(unsigned, b); }
__device__ __forceinline__ s16x4_t vtr(const LAS unsigned char* p) { return __builtin_bit_cast(s16x4_t, __builtin_amdgcn_ds_read_tr16_b64_v4i16((LAS s16x4_t*)p)); }

__device__ __forceinline__ void attn_stage(Frame& F, int row0, int nkeys, int kvh, int voff) {
    for (int idx = F.tid; idx < nkeys * 8; idx += NWAVES * 64) { const int key = idx >> 3, c = idx & 7;
        const bf16* src = F.u + u_idx(row0 + key, OFF_K + kvh * HD + 8 * c);
        const v4u kv = *(const v4u*)(src), vv = *(const v4u*)(src + (OFF_V - OFF_K));
        *(LAS v4u*)(F.lds + key * KSTR + 16 * c) = kv; *(LAS v4u*)(F.lds + voff + key * VSTR + 16 * c) = vv; }
}
template <int MASK> __device__ __forceinline__ void attn_half_tile(bf16x8_t (&ka)[4], const LAS unsigned char* kpn_, const LAS unsigned char* vp_, const bf16x8_t (&qf)[2][4], f32x16 (&o)[2][2], float (&lsum)[2], float negshift, int hh, int kb, int qi0) {
    unsigned kpi = (unsigned)(size_t)kpn_, vpi = (unsigned)(size_t)vp_; asm volatile("" : "+v"(kpi), "+v"(vpi));
    const LAS unsigned char* kpn = (const LAS unsigned char*)(size_t)kpi; const LAS unsigned char* vp = (const LAS unsigned char*)(size_t)vpi;
    f32x16 p0, p1;
#pragma unroll
    for (int r = 0; r < 16; ++r) { p0[r] = negshift; p1[r] = negshift; }
#pragma unroll
    for (int ds = 0; ds < 4; ++ds) { p0 = __builtin_amdgcn_mfma_f32_32x32x16_bf16(ka[ds], qf[0][ds], p0, 0, 0, 0); p1 = __builtin_amdgcn_mfma_f32_32x32x16_bf16(ka[ds], qf[1][ds], p1, 0, 0, 0); }
    __builtin_amdgcn_sched_barrier(0);
#pragma unroll
    for (int ds = 0; ds < 4; ++ds) ka[ds] = *(const LAS bf16x8_t*)(kpn + ds * 32);
    s16x4_t vlo[2], vhi[2];
#pragma unroll
    for (int db = 0; db < 2; ++db) { vlo[db] = vtr(vp + db * 64); vhi[db] = vtr(vp + 8 * VSTR + db * 64); }
    __builtin_amdgcn_sched_barrier(0);
    float s0 = 0.f, s1 = 0.f;
#pragma unroll
    for (int r = 0; r < 16; ++r) {
        float e0 = __builtin_amdgcn_exp2f(p0[r]), e1 = __builtin_amdgcn_exp2f(p1[r]);
        if (MASK == 1) { const int kidx = kb + crow(r, hh); e0 = (kidx >= qi0) ? e0 : 0.f; e1 = (kidx >= qi0 + 32) ? e1 : 0.f; }
        if (MASK == 2) { const int kidx = kb + crow(r, hh); e0 = (kidx <= qi0) ? e0 : 0.f; e1 = (kidx <= qi0 + 32) ? e1 : 0.f; }
        p0[r] = e0; p1[r] = e1; s0 += e0; s1 += e1; }
    lsum[0] += s0; lsum[1] += s1;
#pragma unroll
    for (int ks = 0; ks < 2; ++ks) {
        v4u w0, w1;
        w0.x = cvtpk_s(p0[8 * ks + 0], p0[8 * ks + 1]); w0.y = cvtpk_s(p0[8 * ks + 2], p0[8 * ks + 3]); w0.z = cvtpk_s(p0[8 * ks + 4], p0[8 * ks + 5]); w0.w = cvtpk_s(p0[8 * ks + 6], p0[8 * ks + 7]);
        w1.x = cvtpk_s(p1[8 * ks + 0], p1[8 * ks + 1]); w1.y = cvtpk_s(p1[8 * ks + 2], p1[8 * ks + 3]); w1.z = cvtpk_s(p1[8 * ks + 4], p1[8 * ks + 5]); w1.w = cvtpk_s(p1[8 * ks + 6], p1[8 * ks + 7]);
        const bf16x8_t pa0 = __builtin_bit_cast(bf16x8_t, w0), pa1 = __builtin_bit_cast(bf16x8_t, w1);
        bf16x8_t vf[2];
#pragma unroll
        for (int db = 0; db < 2; ++db) vf[db] = (bf16x8_t){vlo[db][0], vlo[db][1], vlo[db][2], vlo[db][3], vhi[db][0], vhi[db][1], vhi[db][2], vhi[db][3]};
        if (ks == 0) {
#pragma unroll
            for (int db = 0; db < 2; ++db) { vlo[db] = vtr(vp + 16 * VSTR + db * 64); vhi[db] = vtr(vp + 24 * VSTR + db * 64); }
            __builtin_amdgcn_sched_barrier(0);
        }
#pragma unroll
        for (int db = 0; db < 2; ++db) {
            o[0][db] = __builtin_amdgcn_mfma_f32_32x32x16_bf16(pa0, vf[db], o[0][db], 0, 0, 0);
            o[1][db] = __builtin_amdgcn_mfma_f32_32x32x16_bf16(pa1, vf[db], o[1][db], 0, 0, 0); }
    }
}
__device__ __forceinline__ void attn_unit(Frame& F, int layer, int item) {
    const int lane = F.lane, wave = F.wave, r32 = lane & 31, hh = lane >> 5;
    const bool lat = item < NBATCH * NKV * (SEQ / 128);
    int b, kvh, qb, qrow0;
    if (lat) { b = item / (NKV * (SEQ / 128)); const int r = item % (NKV * (SEQ / 128)); kvh = r / (SEQ / 128); qb = r % (SEQ / 128); qrow0 = b * SEQ + qb * 128; }
    else { const int it = item - NBATCH * NKV * (SEQ / 128); b = it >> 2; kvh = (it >> 1) & 1; qb = it & 1; qrow0 = MLAT + b * CTXL + qb * 128; }
    const int crow0 = MLAT + b * CTXL;
    const int h = kvh * 4 + (wave >> 1), th = wave & 1;
    float mq = fabsf(F.q_norm_g[layer * HD + lane]), mk = fabsf(F.k_norm_g[layer * HD + lane]);
    mq = xmaxk<1>(mq); mq = xmaxk<2>(mq); mq = xmaxk<4>(mq); mq = xmaxk<8>(mq); mq = xmaxk<16>(mq); mq = xmaxk<32>(mq);
    mk = xmaxk<1>(mk); mk = xmaxk<2>(mk); mk = xmaxk<4>(mk); mk = xmaxk<8>(mk); mk = xmaxk<16>(mk); mk = xmaxk<32>(mk);
    const float shift = 8.0f * 1.03f * 1.4426950408889634f * mq * mk, negshift = -shift;
    bf16x8_t qf[2][4];
#pragma unroll
    for (int s = 0; s < 2; ++s) { const bf16* qp = F.u + u_idx(qrow0 + 64 * th + 32 * s + r32, OFF_Q + h * HD + 8 * hh);
#pragma unroll
        for (int ds = 0; ds < 4; ++ds) qf[s][ds] = *(const bf16x8_t*)(qp + 16 * ds); }
    f32x16 o[2][2];
#pragma unroll
    for (int s = 0; s < 2; ++s)
#pragma unroll
        for (int db = 0; db < 2; ++db)
#pragma unroll
            for (int r = 0; r < 16; ++r) o[s][db][r] = 0.f;
    float lsum[2] = {0.f, 0.f};
    const int qi0 = 64 * th + r32;
    const int kfo = r32 * KSTR + hh * 16;
    const int vfo = (4 * hh + ((lane & 15) >> 2)) * VSTR + (16 * ((lane >> 4) & 1) + 4 * (lane & 3)) * 2;
    const LAS unsigned char* L = F.lds;
    bf16x8_t ka[4];
    if (lat) {
        const int s_lo = (qb == 0) ? 128 : 0, s_hi = (qb == SEQ / 128 - 1) ? 256 : 384;
        {
            const int row_s0 = b * SEQ + 128 * (qb - 1);
            v4u kr[6], vr[6];
#pragma unroll
            for (int i = 0; i < 6; ++i) { const int idx = F.tid + 512 * i, key = idx >> 3, c = idx & 7; const int keyc = (key >= s_lo && key < s_hi) ? key : 128;
                const bf16* src = F.u + u_idx(row_s0 + keyc, OFF_K + kvh * HD + 8 * c); kr[i] = *(const v4u*)(src); vr[i] = *(const v4u*)(src + (OFF_V - OFF_K)); }
            __syncthreads();
#pragma unroll
            for (int i = 0; i < 6; ++i) { const int idx = F.tid + 512 * i, key = idx >> 3, c = idx & 7;
                *(LAS v4u*)(F.lds + key * KSTR + 16 * c) = kr[i]; *(LAS v4u*)(F.lds + ATT_VA + key * VSTR + 16 * c) = vr[i]; }
        }
        __syncthreads();
        {
            const LAS unsigned char* k0 = L + ((qb > 0) ? 64 * th : 128) * KSTR + kfo;
#pragma unroll
            for (int ds = 0; ds < 4; ++ds) ka[ds] = *(const LAS bf16x8_t*)(k0 + ds * 32);
        }
        if (qb > 0) {
#pragma unroll 1
            for (int hk = 2 * th; hk < 4; ++hk) attn_half_tile<1>(ka, L + (32 * hk + 32) * KSTR + kfo, L + ATT_VA + (32 * hk) * VSTR + vfo, qf, o, lsum, negshift, hh, 32 * hk, qi0);
        }
#pragma unroll 1
        for (int hk = 0; hk < 4; ++hk) attn_half_tile<0>(ka, L + (128 + 32 * hk + 32) * KSTR + kfo, L + ATT_VA + (128 + 32 * hk) * VSTR + vfo, qf, o, lsum, negshift, hh, 0, 0);
        if (qb < SEQ / 128 - 1) {
#pragma unroll 1
            for (int hk = 0; hk < 2 * th + 2; ++hk) attn_half_tile<2>(ka, L + (256 + 32 * hk + 32) * KSTR + kfo, L + ATT_VA + (256 + 32 * hk) * VSTR + vfo, qf, o, lsum, negshift, hh, 32 * hk, qi0);
        }
    }
    {
        v4u kr[4], vr[4];
#pragma unroll
        for (int i = 0; i < 4; ++i) { const int idx = F.tid + 512 * i, key = idx >> 3, c = idx & 7;
            const bf16* src = F.u + u_idx(crow0 + key, OFF_K + kvh * HD + 8 * c); kr[i] = *(const v4u*)(src); vr[i] = *(const v4u*)(src + (OFF_V - OFF_K)); }
        __syncthreads();
#pragma unroll
        for (int i = 0; i < 4; ++i) { const int idx = F.tid + 512 * i, key = idx >> 3, c = idx & 7;
            *(LAS v4u*)(F.lds + key * KSTR + 16 * c) = kr[i]; *(LAS v4u*)(F.lds + ATT_VB + key * VSTR + 16 * c) = vr[i]; }
    }
    __syncthreads();
#pragma unroll
    for (int ds = 0; ds < 4; ++ds) ka[ds] = *(const LAS bf16x8_t*)(L + kfo + ds * 32);
#pragma unroll 1
    for (int hk = 0; hk < 8; ++hk) attn_half_tile<0>(ka, L + (32 * hk + 32) * KSTR + kfo, L + ATT_VB + (32 * hk) * VSTR + vfo, qf, o, lsum, negshift, hh, 0, 0);
    const float sinkt = __builtin_amdgcn_exp2f(F.attn_sink[layer * NHEAD + h] * 1.4426950408889634f - shift);
    LAS float* lw = (LAS float*)(F.lds + ATT_LW + wave * 256);
    LAS bf16* stg = (LAS bf16*)(F.lds + ATT_OST + wave * 4096);
#pragma unroll
    for (int s = 0; s < 2; ++s) { const float lt = xadd32(lsum[s]) + sinkt; if (hh == 0) lw[s * 32 + r32] = 1.0f / lt; }
    LDS_WAIT(); asm volatile("" ::: "memory");
    int sb_w = ATT_OST + wave * 4096 + (4 * hh * 64 + r32) * 2, lb_r = ATT_LW + wave * 256 + 4 * hh * 4, sb_r = ATT_OST + wave * 4096 + ((lane >> 3) * 64 + (lane & 7) * 8) * 2;
    asm volatile("" : "+v"(sb_w), "+v"(lb_r), "+v"(sb_r));
#pragma unroll
    for (int s = 0; s < 2; ++s) {
#pragma unroll
        for (int r = 0; r < 16; ++r) { const int ro = (r & 3) + 8 * (r >> 2); const float inv = *(const LAS float*)(F.lds + lb_r + (s * 32 + ro) * 4);
#pragma unroll
            for (int db = 0; db < 2; ++db) *(LAS bf16*)(F.lds + sb_w + (ro * 64 + db * 32) * 2) = (bf16)f2bf(o[s][db][r] * inv); }
        LDS_WAIT(); asm volatile("" ::: "memory");
        bf16* yp = F.y + (size_t)(qrow0 + 64 * th + 32 * s + (lane >> 3)) * DM + 256 + h * HD + (lane & 7) * 8;
#pragma unroll
        for (int i = 0; i < 4; ++i) { const v4u v = *(const LAS v4u*)(F.lds + sb_r + i * 8 * 64 * 2); *(v4u*)(yp + (size_t)(i * 8) * DM) = v; }
        LDS_WAIT(); asm volatile("" ::: "memory");
    }
}
__device__ __forceinline__ void mixer_attn_phase(Frame& F, int layer) {
    const bool last = layer == NLAYER - 1;
    const int nunits = NBATCH * NKV * (SEQ / 128) + (last ? 0 : NBATCH * NKV * 2);
    for (int rep = 0; rep < REP_ATT; ++rep)
    for (int it = blockIdx.x; it < nunits; it += F.G) attn_unit(F, layer, it);
}
__device__ __forceinline__ void mixer_conv_phase(Frame& F, int layer) {
    const bool last = layer == NLAYER - 1;
    const int ntiles = (last ? MLAT : MTOT) / 64;
    const int nlat = MLAT / 64, nlr = (nlat - (int)blockIdx.x + F.G - 1) / F.G;
    for (int rep = 0; rep < REP_CONV; ++rep)
    for (int i = 0; ; ++i) { const int ti = (i < nlr) ? (int)blockIdx.x + i * F.G : nlat + (F.G - 1 - (int)blockIdx.x) + (i - nlr) * F.G; if (ti >= ntiles) break; conv_tile(F, layer, ti); }
}

constexpr int N_PHASES = 2 + 5 * NLAYER;
typedef const __attribute__((address_space(4))) Args* KArgs;
__device__ __forceinline__ void make_frame(Frame& F, KArgs a, LAS unsigned char* lds) {
    asm volatile("" : "+s"(a));
    F.lds = lds;
    { int t_ = threadIdx.x; asm volatile("" : "+v"(t_)); F.tid = t_; } F.lane = F.tid & 63; F.wave = __builtin_amdgcn_readfirstlane(F.tid >> 6);
    F.G = gridDim.x; { const int bx = blockIdx.x; F.vcu = (F.G % 8 == 0) ? (bx % 8) * (F.G / 8) + bx / 8 : bx; }
    F.x = a->in[0]; F.c = a->in[1]; F.ctx = a->in[2]; F.c_ctx = a->in[3]; F.w_mod = a->in[4]; F.b_mod = a->in[5]; F.norm1_g = a->in[6]; F.w_in = a->in[7];
    F.conv_a_w = a->in[8]; F.q_norm_g = a->in[9]; F.k_norm_g = a->in[10]; F.attn_sink = a->in[11]; F.conv_c_w = a->in[12]; F.conv_c_b = a->in[13]; F.ln_c_g = a->in[14]; F.ln_c_b = a->in[15];
    F.w_out = a->in[16]; F.norm2_g = a->in[17]; F.w_mlp1 = a->in[18]; F.w_mlp2 = a->in[19];
    F.out = a->out;
    unsigned char* ws = a->ws;
    F.modp = (float*)(ws + WS_MODP); F.mod = (float*)(ws + WS_MOD); F.bias1 = (float*)(ws + WS_BIAS1); F.bias2 = (float*)(ws + WS_BIAS2); F.rope = (float*)(ws + WS_ROPE);
    F.stat1 = (float*)(ws + WS_STAT1); F.stat2 = (float*)(ws + WS_STAT2); F.statc1 = (float*)(ws + WS_STATC1); F.statc2 = (float*)(ws + WS_STATC2); F.xc = (float*)(ws + WS_XC);
    F.win_t = (bf16*)(ws + WS_WIN); F.wout_t = (bf16*)(ws + WS_WOUT); F.w1_t = (bf16*)(ws + WS_W1); F.w2_t = (bf16*)(ws + WS_W2);
    F.xb = (bf16*)(ws + WS_XB); F.u = (bf16*)(ws + WS_U); F.y = (bf16*)(ws + WS_Y); F.h = (bf16*)(ws + WS_H);
}
__global__ void __launch_bounds__(NWAVES * 64, 2) mk_fwd(Args args_unused) {
    extern __shared__ __attribute__((aligned(16))) unsigned char lds[];
    LAS unsigned char* const ldsp = (LAS unsigned char*)lds;
    const KArgs ka = (KArgs)__builtin_amdgcn_kernarg_segment_ptr();
    const int tid0 = threadIdx.x;
    for (int u = tid0; u < (LDS_BYTES - LDSCTL_OFF) / 4; u += NWAVES * 64) ((LAS unsigned*)(ldsp + LDSCTL_OFF))[u] = 0u;
    __syncthreads();
    const int lo = ka->ph_lo, hi = ka->ph_hi;
#if MK_PER_PHASE
#define GRID_BAR() do { } while (0)
#else
    XcdBarrier bar = xcd_barrier_post((unsigned*)((gu32*)(ka->ws + WS_CTL) + CW_BAR), (volatile LAS unsigned*)(ldsp + MISC_OFF) + 8);
#define GRID_BAR() xcd_barrier(bar)
#endif
#define IN(k) (lo <= (k) && (k) < hi)
#define SEAM(k) do { if (IN(k) && IN((k) + 1)) GRID_BAR(); } while (0)

    for (int rep01 = 0; rep01 < REP_P01; ++rep01) {
#ifndef SKP0
    if (IN(0)) { Frame F; make_frame(F, ka, ldsp); p0_phase(F); }
#endif
    SEAM(0);
#ifndef SKP1
    if (IN(1)) { Frame F; make_frame(F, ka, ldsp); p1_phase(F); }
#endif
    SEAM(1);
    }
#pragma unroll 1
    for (int layer = 0; layer < NLAYER; ++layer) {
        const int pb = 2 + 5 * layer; const bool last = layer == NLAYER - 1;
#ifndef SKG0
        if (IN(pb + 0)) for (int rep = 0; rep < REP_G0; ++rep) {
            Frame F; make_frame(F, ka, ldsp);
            const bf16* wv2 = F.win_t + (size_t)layer * 3 * DIN * DM + (size_t)2 * DIN * DM;
#if defined(PROBE_LDC)
            if (layer == 0) { pg8::Gemm g{F.h, F.win_t + (size_t)layer * 3 * DIN * DM, MLAT, DIN, DM, (size_t)DIN * DM * 2, PROBE_LDA}; pg8::StaticOrder S; S.init(MLAT, DIN, F.G, (int)blockIdx.x); pg8::EpiNormAct<0> Ed{F.h, PROBE_LDC, F.stat1, F.bias1 + (size_t)layer * 3 * DIN, DIN, DIN, pg8::EpiTabs{(LAS int*)(ldsp + EPI_US_OFF), (LAS float*)(ldsp + EPI_RS_OFF), (LAS float*)(ldsp + EPI_BT_OFF), (LAS float*)(ldsp + EPI_S_OFF), (LAS float*)(ldsp + EPI_B1_OFF)}, EPS};
                pg8::gemm_phase<pg8::EpiNormAct<0>, pg8::StaticOrder, true, true>(ldsp + RING_OFF, g, S, Ed); }
#endif
            ctx_gemm<0>(F, F.xb + (size_t)MLAT * DM, wv2, DM, last ? OFF_K / 64 : 0, last ? (OFF_C - OFF_K) / 64 : DIN / 64, F.u, DIN, F.statc1, F.bias1 + ((size_t)layer * 3 + 2) * DIN, nullptr, nullptr, nullptr, F.q_norm_g + layer * HD, F.k_norm_g + layer * HD);
            pg8::Gemm g{F.xb, F.win_t + (size_t)layer * 3 * DIN * DM, MLAT, DIN, DM, (size_t)DIN * DM * 2};
            pg8::StaticOrder S; S.init(MLAT, DIN, F.G, (int)blockIdx.x);
            pg8::EpiIn E{F.u, F.stat1, F.bias1 + (size_t)layer * 3 * DIN, F.q_norm_g + layer * HD, F.k_norm_g + layer * HD, F.rope, pg8::EpiTabs{(LAS int*)(ldsp + EPI_US_OFF), (LAS float*)(ldsp + EPI_RS_OFF), (LAS float*)(ldsp + EPI_BT_OFF), (LAS float*)(ldsp + EPI_S_OFF), (LAS float*)(ldsp + EPI_B1_OFF)}, (LAS float*)(ldsp + EPI_P_OFF)  , EPS, QSCALE};
            pg8::gemm_phase<pg8::EpiIn, pg8::StaticOrder, true, true>(ldsp + RING_OFF, g, S, E);
        }
#endif
        SEAM(pb + 0);
#ifndef SKMX
        if (IN(pb + 1)) { for (int rep = 0; rep < REP_MIX; ++rep) { Frame F; make_frame(F, ka, ldsp); mixer_attn_phase(F, layer); } { Frame F; make_frame(F, ka, ldsp); mixer_conv_phase(F, layer); } }
#endif
        SEAM(pb + 1);
#ifndef SKG3
        if (IN(pb + 2)) {
            Frame F; make_frame(F, ka, ldsp);
            if (!last) ctx_gemm<1>(F, F.y + (size_t)MLAT * DM, F.wout_t + (size_t)layer * DM * DM, DM, 0, DM / 64, F.xb, DM, nullptr, F.mod + ((size_t)layer * 3 + 2) * MODW + 2 * DM, F.ctx, F.xc, F.statc2);
            pg8::Gemm g{F.y, F.wout_t + (size_t)layer * DM * DM, MLAT, DM, DM, 0};
            pg8::StaticOrder S; S.init(MLAT, DM, F.G, (int)blockIdx.x);
            for (int rep = 1; rep < REP_G2; ++rep) { pg8::EpiRes<false> E{F.xb, (bf16*)(ka->ws + WS_SCRATCH), nullptr, F.mod + (size_t)layer * 3 * MODW + 2 * DM, MODW, (float*)(ka->ws + WS_SCRATCH + 80 * MiB), (LAS float*)(ldsp + EPI_P_OFF)};
                pg8::gemm_phase<pg8::EpiRes<false>, pg8::StaticOrder, true, true>(ldsp + RING_OFF, g, S, E); }
            pg8::EpiRes<false> E{F.xb, F.xb, nullptr, F.mod + (size_t)layer * 3 * MODW + 2 * DM, MODW, F.stat2, (LAS float*)(ldsp + EPI_P_OFF)};
            pg8::gemm_phase<pg8::EpiRes<false>, pg8::StaticOrder, true, true>(ldsp + RING_OFF, g, S, E);
        }
#endif
        SEAM(pb + 2);
#ifndef SKG4
        if (IN(pb + 3)) for (int rep = 0; rep < REP_G4; ++rep) {
            Frame F; make_frame(F, ka, ldsp);
            int par = ((int)blockIdx.x >> 3) & 1; asm volatile("" : "+s"(par));
#pragma unroll 1
            for (int pass = 0; pass < 2; ++pass) {
            if (pass == par) {
            if (!last) ctx_gemm<2>(F, F.xb + (size_t)MLAT * DM, F.w1_t + (size_t)layer * 3 * DFF * DM + (size_t)2 * DFF * DM, DM, 0, DFF / 64, F.h, DFF, F.statc2, F.bias2 + ((size_t)layer * 3 + 2) * DFF, nullptr, nullptr, nullptr);
            } else {
            pg8::Gemm g{F.xb, F.w1_t + (size_t)layer * 3 * DFF * DM, MLAT, DFF, DM, (size_t)DFF * DM * 2};
            pg8::StaticOrder S; S.init(MLAT, DFF, F.G, (int)blockIdx.x);
            pg8::EpiNormAct<1> E{F.h, DM, F.stat2, F.bias2 + (size_t)layer * 3 * DFF, DFF, DFF, pg8::EpiTabs{(LAS int*)(ldsp + EPI_US_OFF), (LAS float*)(ldsp + EPI_RS_OFF), (LAS float*)(ldsp + EPI_BT_OFF), (LAS float*)(ldsp + EPI_S_OFF), (LAS float*)(ldsp + EPI_B1_OFF)}, EPS, (size_t)MLAT * DM};
            pg8::gemm_phase<pg8::EpiNormAct<1>, pg8::StaticOrder, true, true>(ldsp + RING_OFF, g, S, E);
            } }
        }
#endif
        SEAM(pb + 3);
#ifndef SKG5
        if (IN(pb + 4)) {
            Frame F; make_frame(F, ka, ldsp);
            if (!last) ctx_gemm<1>(F, F.h + (size_t)MLAT * DFF, F.w2_t + (size_t)layer * DM * DFF, DFF, 0, DM / 64, F.xb, DM, nullptr, F.mod + ((size_t)layer * 3 + 2) * MODW + 5 * DM, F.xc, F.xc, F.statc1);
            pg8::Gemm g{F.h, F.w2_t + (size_t)layer * DM * DFF, MLAT, DM, DFF, 0, DM, (size_t)MLAT * DM * 2};
            pg8::StaticOrder S; S.init(MLAT, DM, F.G, (int)blockIdx.x);
            for (int rep = 1; rep < REP_G5; ++rep) { pg8::EpiRes<false> E{F.xb, (bf16*)(ka->ws + WS_SCRATCH), nullptr, F.mod + (size_t)layer * 3 * MODW + 5 * DM, MODW, (float*)(ka->ws + WS_SCRATCH + 80 * MiB), (LAS float*)(ldsp + EPI_P_OFF)};
                pg8::gemm_phase<pg8::EpiRes<false>, pg8::StaticOrder, true, true>(ldsp + RING_OFF, g, S, E); }
            if (!last) { pg8::EpiRes<false> E{F.xb, F.xb, nullptr, F.mod + (size_t)layer * 3 * MODW + 5 * DM, MODW, F.stat1, (LAS float*)(ldsp + EPI_P_OFF)};
                pg8::gemm_phase<pg8::EpiRes<false>, pg8::StaticOrder, true, true>(ldsp + RING_OFF, g, S, E); }
            else { pg8::EpiRes<true> E{F.xb, nullptr, F.out, F.mod + (size_t)layer * 3 * MODW + 5 * DM, MODW, nullptr, (LAS float*)(ldsp + EPI_P_OFF)};
                pg8::gemm_phase<pg8::EpiRes<true>, pg8::StaticOrder, true, true>(ldsp + RING_OFF, g, S, E); }
        }
#endif
        if (!last) SEAM(pb + 4);
    }
#undef IN
#undef SEAM
}

extern "C" void kernel_launch(void* const* d_in, const int* in_sizes, int n_in, void* d_out, int out_size, void* d_ws, size_t ws_size, hipStream_t stream) {
    static int grid = 0;
    if (grid == 0) {
        if (n_in != 20 || in_sizes[0] != MLAT * DM || out_size != MLAT * DM || ws_size < WS_END) {
            fprintf(stderr, "kernel_launch: unexpected shapes: n_in %d in0 %d out %d ws %zu (need >= %zu); nothing launched\n", n_in, n_in > 0 ? in_sizes[0] : -1, out_size, ws_size, (size_t)WS_END); grid = -1; return; }
        int dev = 0, cus = 0;
        if (hipGetDevice(&dev) != hipSuccess || hipDeviceGetAttribute(&cus, hipDeviceAttributeMultiprocessorCount, dev) != hipSuccess) { fprintf(stderr, "kernel_launch: device query failed\n"); grid = -1; return; }
        if (hipFuncSetAttribute((const void*)mk_fwd, hipFuncAttributeMaxDynamicSharedMemorySize, LDS_BYTES) != hipSuccess) { fprintf(stderr, "kernel_launch: hipFuncSetAttribute failed\n"); grid = -1; return; }
        int per_cu = 0;
        if (hipOccupancyMaxActiveBlocksPerMultiprocessor(&per_cu, (const void*)mk_fwd, NWAVES * 64, LDS_BYTES) != hipSuccess || per_cu < 1)
            fprintf(stderr, "kernel_launch: note: occupancy query reports %d workgroups per CU\n", per_cu);
        (void)hipGetLastError();
        grid = cus;
    }
    if (grid < 0) return;
    if (hipMemsetAsync((char*)d_ws + WS_CTL, 0, CTL_ZERO_BYTES, stream) != hipSuccess) { fprintf(stderr, "kernel_launch: memset failed\n"); return; }
    Args a{};
    for (int i = 0; i < 20; ++i) a.in[i] = (const float*)d_in[i];
    a.out = (float*)d_out; a.ws = (unsigned char*)d_ws;
#if MK_PER_PHASE
    for (int ph = 0; ph < N_PHASES; ++ph) {
        a.ph_lo = ph; a.ph_hi = ph + 1;
        hipLaunchKernelGGL(mk_fwd, dim3(grid), dim3(NWAVES * 64), LDS_BYTES, stream, a);
    }
#else
    a.ph_lo = 0; a.ph_hi = N_PHASES;
    hipLaunchKernelGGL(mk_fwd, dim3(grid), dim3(NWAVES * 64), LDS_BYTES, stream, a);
#endif
    const hipError_t le = hipPeekAtLastError();
    if (le != hipSuccess) fprintf(stderr, "kernel_launch: launch failed: %s\n", hipGetErrorName(le));
}
```
